# Optimizing an MI355X kernel written in HIP

```python
import jax
import jax.numpy as jnp
from jax import lax
import numpy as np

D_MODEL = 1024
BATCH = 2
SEQ = 8192
DEPTH = 4

CTX_LEN = 256
GRID_W = 64

M_HEADS = 8
M_HEAD_DIM = 128
M_WIDTH = M_HEADS * M_HEAD_DIM
M_CHUNK = 128
M_CONV = 3
M_STAB_INIT = -1e30

S_GROUPS = 8
S_WIDTH = 1024
S_GROUP_DIM = S_WIDTH // S_GROUPS
S_CHUNK = 128

N_KEYS = 128
N_EXPERTS = N_KEYS * N_KEYS
PEER_HEADS = 8
PEER_TOPK = 16
PEER_QDIM = 256
PEER_HALF = PEER_QDIM // 2
PEER_BLOCK = 128

N_GATES = 4 * M_HEADS
IN_SPLITS = (2 * M_WIDTH, 3 * M_WIDTH, 4 * M_WIDTH, 4 * M_WIDTH + N_GATES,
             4 * M_WIDTH + N_GATES + S_WIDTH, 4 * M_WIDTH + N_GATES + 2 * S_WIDTH,
             4 * M_WIDTH + N_GATES + 2 * S_WIDTH + D_MODEL)
IN_WIDTH = IN_SPLITS[-1] + D_MODEL

DN_ALPHA = (2 * DEPTH) ** 0.25
DN_BETA = (8 * DEPTH) ** -0.25
LN_EPS = 1e-5

kernel_name = 'hybrid_mlstm_sgu_peer_dit'


def _standardize(a):
    af = a.astype(jnp.float32)
    mu = jnp.mean(af, axis=-1, keepdims=True)
    var = jnp.mean(jnp.square(af - mu), axis=-1, keepdims=True)
    return (af - mu) * lax.rsqrt(var + LN_EPS)


def layer_norm(a, w, b):
    return (_standardize(a) * w + b).astype(a.dtype)


def conv_grid(a, w, b, rows):
    B_, T, C = a.shape
    img = a.reshape(B_, rows, GRID_W, C)
    out = lax.conv_general_dilated(img, w[:, :, None, :], window_strides=(1, 1), padding='SAME',
                                   dimension_numbers=('NHWC', 'HWIO', 'NHWC'),
                                   feature_group_count=C)
    return out.reshape(B_, T, C) + b


def conv_seq(a, w_row, b):
    ap = jnp.pad(a, ((0, 0), (1, 1), (0, 0)))
    return ap[:, :-2] * w_row[0] + ap[:, 1:-1] * w_row[1] + ap[:, 2:] * w_row[2] + b


def zero_state(b):
    return (jnp.zeros((b, M_HEADS, M_HEAD_DIM, M_HEAD_DIM), jnp.float32),
            jnp.zeros((b, M_HEADS, M_HEAD_DIM), jnp.float32),
            jnp.full((b, M_HEADS), M_STAB_INIT, jnp.float32))


def mlstm_chunked(q, k, v, log_i, log_f, state):
    B_, H, T, dh = q.shape
    nc = T // M_CHUNK

    def to_chunks(a):
        a = a.reshape(B_, H, nc, M_CHUNK, *a.shape[3:])
        return jnp.moveaxis(a, 2, 0)

    xs = (to_chunks(q), to_chunks(k), to_chunks(v), to_chunks(log_i), to_chunks(log_f))
    tri = jnp.tril(jnp.ones((M_CHUNK, M_CHUNK), dtype=bool))

    def step(carry, inp):
        C, n, m = carry
        qc, kc, vc, ic, fc = inp
        b = jnp.cumsum(fc, axis=-1)
        d = jnp.where(tri, b[..., :, None] - b[..., None, :] + ic[..., None, :], -jnp.inf)
        inter = b + m[..., None]
        m_t = jnp.maximum(inter, jnp.max(d, axis=-1))
        a_t = jnp.exp(inter - m_t)
        s = jnp.einsum('bhtk,bhsk->bhts', qc, kc) * jnp.exp(d - m_t[..., None])
        num = a_t[..., None] * jnp.einsum('bhvk,bhtk->bhtv', C, qc) + jnp.einsum('bhts,bhsv->bhtv', s, vc)
        den = a_t * jnp.einsum('bhk,bhtk->bht', n, qc) + jnp.sum(s, axis=-1)
        h = num / jnp.maximum(jnp.abs(den), jnp.exp(-m_t))[..., None]
        g = b[..., -1]
        dl = g[..., None] - b + ic
        m_new = jnp.maximum(g + m, jnp.max(dl, axis=-1))
        wl = jnp.exp(dl - m_new[..., None])
        a_l = jnp.exp(g + m - m_new)
        C = a_l[..., None, None] * C + jnp.einsum('bhsv,bhsk->bhvk', vc * wl[..., None], kc)
        n = a_l[..., None] * n + jnp.einsum('bhs,bhsk->bhk', wl, kc)
        return (C, n, m_new), h

    final, hs = lax.scan(step, state, xs)
    return jnp.moveaxis(hs, 0, 2).reshape(B_, H, T, dh), final


def mlstm_prepare(qk, v, gates, gate_b):
    B_, T, _ = v.shape

    def heads(a):
        return a.reshape(B_, T, M_HEADS, M_HEAD_DIM).transpose(0, 2, 1, 3).astype(jnp.float32)

    q, k = jnp.split(qk, 2, axis=-1)
    g = (gates + gate_b).astype(jnp.float32).transpose(0, 2, 1)
    i_f, f_f, i_b, f_b = jnp.split(g, 4, axis=1)
    return (heads(q) * M_HEAD_DIM ** -0.5, heads(k), heads(v),
            (i_f, jax.nn.log_sigmoid(f_f)), (i_b, jax.nn.log_sigmoid(f_b)))


def mlstm_bidir(q, k, v, fwd, bwd, state_f, state_b):
    h_f, st_f = mlstm_chunked(q, k, v, fwd[0], fwd[1], state_f)
    rev = lambda a: jnp.flip(a, axis=2)
    h_b, st_b = mlstm_chunked(rev(q), rev(k), rev(v), rev(bwd[0]), rev(bwd[1]), state_b)
    return h_f + rev(h_b), st_f, st_b


def mlstm_readout(h, o, norm_w):
    B_, H, T, dh = h.shape
    hn = _standardize(h).transpose(0, 2, 1, 3).reshape(B_, T, M_WIDTH) * norm_w
    return (jax.nn.sigmoid(o.astype(jnp.float32)) * hn).astype(o.dtype)


def spatial_gating(u, vg, norm_w, w_s, b_s):
    B_, T, _ = u.shape
    zv = (_standardize(jax.nn.gelu(vg)) * norm_w).astype(vg.dtype)
    zv = zv.reshape(B_, T // S_CHUNK, S_CHUNK, S_GROUPS, S_GROUP_DIM)
    mixed = jnp.einsum('gpq,bnqgc->bnpgc', w_s, zv) + b_s.T[:, :, None]
    return jax.nn.gelu(u) * mixed.reshape(B_, T, S_WIDTH)


def branch_merge(h_a, h_b, ga, gb, branch_b, p_a, p_b, w_out):
    ba, bb = jnp.split(branch_b, 2)
    merged = jax.nn.sigmoid(ga + ba) * (h_a @ p_a) + jax.nn.sigmoid(gb + bb) * (h_b @ p_b)
    return merged @ w_out


def token_mixer(hc, hx, rows, w_in, qk_conv_w, qk_conv_b, gate_b, mlstm_norm_w, sgu_norm_w,
                sgu_w, sgu_b, branch_b, p_a, p_b, w_out, ctx_out):
    qk_c, v_c, o_c, gt_c, u_c, vg_c, ga_c, gb_c = jnp.split(hc @ w_in, IN_SPLITS, axis=-1)
    qk_x, v_x, o_x, gt_x, u_x, vg_x, ga_x, gb_x = jnp.split(hx @ w_in, IN_SPLITS, axis=-1)
    qk_c = jax.nn.silu(conv_seq(qk_c, qk_conv_w[M_CONV // 2], qk_conv_b))
    qk_x = jax.nn.silu(conv_grid(qk_x, qk_conv_w, qk_conv_b, rows))
    q_c, k_c, vh_c, fwd_c, bwd_c = mlstm_prepare(qk_c, v_c, gt_c, gate_b)
    q_x, k_x, vh_x, fwd_x, bwd_x = mlstm_prepare(qk_x, v_x, gt_x, gate_b)
    nb = hc.shape[0]
    h_mc, st_f, st_b = mlstm_bidir(q_c, k_c, vh_c, fwd_c, bwd_c, zero_state(nb), zero_state(nb))
    h_mx, _, _ = mlstm_bidir(q_x, k_x, vh_x, fwd_x, bwd_x, st_f, st_b)
    y_x = branch_merge(mlstm_readout(h_mx, o_x, mlstm_norm_w),
                       spatial_gating(u_x, vg_x, sgu_norm_w, sgu_w, sgu_b),
                       ga_x, gb_x, branch_b, p_a, p_b, w_out)
    if not ctx_out:
        return None, y_x
    y_c = branch_merge(mlstm_readout(h_mc, o_c, mlstm_norm_w),
                       spatial_gating(u_c, vg_c, sgu_norm_w, sgu_w, sgu_b),
                       ga_c, gb_c, branch_b, p_a, p_b, w_out)
    return y_c, y_x


def peer(h, w_q, sub_keys, expert_u, expert_v):
    B_, T, D = h.shape
    blocks = h.reshape(B_ * T // PEER_BLOCK, PEER_BLOCK, D)

    def retrieve(xb):
        qry = (xb @ w_q).reshape(PEER_BLOCK, PEER_HEADS, 2, PEER_HALF)
        scores = jnp.einsum('thpd,hpkd->thpk', qry, sub_keys)
        s_top, i_top = lax.top_k(scores, PEER_TOPK)
        cand_s = (s_top[:, :, 0, :, None] + s_top[:, :, 1, None, :]).reshape(
            PEER_BLOCK, PEER_HEADS, PEER_TOPK * PEER_TOPK)
        cand_i = (i_top[:, :, 0, :, None] * N_KEYS + i_top[:, :, 1, None, :]).reshape(
            PEER_BLOCK, PEER_HEADS, PEER_TOPK * PEER_TOPK)
        s_fin, pos = lax.top_k(cand_s, PEER_TOPK)
        idx = jnp.take_along_axis(cand_i, pos, axis=-1)
        gate = jax.nn.softmax(s_fin.astype(jnp.float32), axis=-1).astype(xb.dtype)
        act = jax.nn.gelu(jnp.einsum('thed,td->the', jnp.take(expert_u, idx, axis=0), xb))
        return jnp.einsum('the,thed->td', gate * act, jnp.take(expert_v, idx, axis=0))

    return lax.map(retrieve, blocks).reshape(B_, T, D)


def setup_inputs(seed: int = 0) -> dict:
    key = jax.random.key(seed)
    ks = jax.random.split(key, 24)

    def nrm(k, shape, s=1.0):
        return s * jax.random.normal(k, shape, jnp.float32)

    f_bias = jnp.linspace(3.0, 6.0, M_HEADS, dtype=jnp.float32)
    zeros_h = jnp.zeros((M_HEADS,), jnp.float32)
    gate_base = jnp.concatenate([zeros_h, f_bias, zeros_h, f_bias])
    return {
        'x': nrm(ks[0], (BATCH, SEQ, D_MODEL)),
        'c': nrm(ks[1], (BATCH, D_MODEL)),
        'ctx': nrm(ks[2], (BATCH, CTX_LEN, D_MODEL)),
        'c_ctx': nrm(ks[3], (D_MODEL,)),
        'w_mod': nrm(ks[4], (DEPTH, D_MODEL, 6 * D_MODEL), 0.5 * D_MODEL ** -0.5),
        'b_mod': nrm(ks[5], (DEPTH, 6 * D_MODEL), 0.02),
        'w_in': nrm(ks[6], (DEPTH, D_MODEL, IN_WIDTH), D_MODEL ** -0.5),
        'qk_conv_w': nrm(ks[7], (DEPTH, M_CONV, M_CONV, 2 * M_WIDTH), 1.0 / M_CONV),
        'qk_conv_b': nrm(ks[8], (DEPTH, 2 * M_WIDTH), 0.02),
        'gate_b': gate_base + nrm(ks[9], (DEPTH, N_GATES), 0.1),
        'mlstm_norm_w': 1.0 + nrm(ks[10], (DEPTH, M_WIDTH), 0.1),
        'sgu_norm_w': 1.0 + nrm(ks[11], (DEPTH, S_WIDTH), 0.1),
        'sgu_w': nrm(ks[12], (DEPTH, S_GROUPS, S_CHUNK, S_CHUNK), S_CHUNK ** -0.5),
        'sgu_b': 1.0 + nrm(ks[13], (DEPTH, S_GROUPS, S_CHUNK), 0.1),
        'branch_b': nrm(ks[14], (DEPTH, 2 * D_MODEL), 0.1),
        'p_a': nrm(ks[15], (DEPTH, M_WIDTH, D_MODEL), DN_BETA * M_WIDTH ** -0.5),
        'p_b': nrm(ks[16], (DEPTH, S_WIDTH, D_MODEL), DN_BETA * S_WIDTH ** -0.5),
        'w_out': nrm(ks[17], (DEPTH, D_MODEL, D_MODEL), DN_BETA * D_MODEL ** -0.5),
        'ln_w': 1.0 + nrm(ks[18], (DEPTH, 2, D_MODEL), 0.1),
        'ln_b': nrm(ks[19], (DEPTH, 2, D_MODEL), 0.02),
        'peer_wq': nrm(ks[20], (DEPTH, D_MODEL, PEER_HEADS * PEER_QDIM), D_MODEL ** -0.5),
        'peer_keys': nrm(ks[21], (DEPTH, PEER_HEADS, 2, N_KEYS, PEER_HALF), PEER_HALF ** -0.5),
        'expert_u': nrm(ks[22], (DEPTH, N_EXPERTS, D_MODEL), D_MODEL ** -0.5),
        'expert_v': nrm(ks[23], (DEPTH, N_EXPERTS, D_MODEL), DN_BETA),
    }


def reference(x, c, ctx, c_ctx, w_mod, b_mod, w_in, qk_conv_w, qk_conv_b, gate_b, mlstm_norm_w,
              sgu_norm_w, sgu_w, sgu_b, branch_b, p_a, p_b, w_out, ln_w, ln_b, peer_wq, peer_keys,
              expert_u, expert_v):
    rows = x.shape[1] // GRID_W
    cond_x = jax.nn.silu(c)
    cond_c = jax.nn.silu(c_ctx)
    zx, zc = x, ctx
    for l in range(DEPTH):
        ctx_live = l < DEPTH - 1
        mx = jnp.split((cond_x @ w_mod[l] + b_mod[l])[:, None, :], 6, axis=-1)
        mc = jnp.split(cond_c @ w_mod[l] + b_mod[l], 6, axis=-1)
        hx = zx * (1.0 + mx[1]) + mx[0]
        hc = zc * (1.0 + mc[1]) + mc[0]
        y_c, y_x = token_mixer(hc, hx, rows, w_in[l], qk_conv_w[l], qk_conv_b[l], gate_b[l],
                               mlstm_norm_w[l], sgu_norm_w[l], sgu_w[l], sgu_b[l], branch_b[l],
                               p_a[l], p_b[l], w_out[l], ctx_live)
        zx = layer_norm(DN_ALPHA * zx + mx[2] * y_x, ln_w[l, 0], ln_b[l, 0])
        hx = zx * (1.0 + mx[4]) + mx[3]
        zx = layer_norm(DN_ALPHA * zx + mx[5] * peer(hx, peer_wq[l], peer_keys[l], expert_u[l], expert_v[l]),
                        ln_w[l, 1], ln_b[l, 1])
        if ctx_live:
            zc = layer_norm(DN_ALPHA * zc + mc[2] * y_c, ln_w[l, 0], ln_b[l, 0])
            hc = zc * (1.0 + mc[4]) + mc[3]
            zc = layer_norm(DN_ALPHA * zc + mc[5] * peer(hc, peer_wq[l], peer_keys[l], expert_u[l], expert_v[l]),
                            ln_w[l, 1], ln_b[l, 1])
    return zx
```

```cpp
#include <hip/hip_runtime.h>
#include <hip/hip_cooperative_groups.h>
#include <cstdio>
namespace cg = cooperative_groups;

#ifndef MEGA
#define MEGA 1
#endif

typedef unsigned short bf16_t;
using bf16x8 = __attribute__((ext_vector_type(8))) short;
using f32x4 = __attribute__((ext_vector_type(4))) float;
#define DEVI __device__ __forceinline__

constexpr int NTX = 16384, NTC = 512, NT = 16896, DEPTH = 4;
constexpr int INW = 8224, INWP = 8320;
constexpr int NITEM = 1056;
constexpr int LDS_BYTES = 79872;
constexpr int NBLK_THREADS = 256;
constexpr float DN_ALPHA = 1.681792830507429f;
constexpr float LN_EPS = 1e-5f;

enum { PH_MOD = 0, PH_PREP, PH_G1, PH_CONV, PH_MLOC, PH_SCAN, PH_MOUT, PH_G2A, PH_G3, PH_LN1, PH_G4, PH_TOPK, PH_GATHER, PH_COUNT };

struct Params {
  const float *x, *c, *ctx, *c_ctx, *w_mod, *b_mod, *w_in, *qk_conv_w, *qk_conv_b, *gate_b, *mlstm_norm_w,
      *sgu_norm_w, *sgu_w, *sgu_b, *branch_b, *p_a, *p_b, *w_out, *ln_w, *ln_b, *peer_wq, *peer_keys, *expert_u, *expert_v;
  float* out;
  float* mod;
  bf16_t* wt_in;
  bf16_t* wt_pa;
  bf16_t* wt_pb;
  bf16_t* wt_out;
  bf16_t* wt_q;
  bf16_t* keys;
  unsigned char* eu;
  unsigned char* ev;
  float* escale;
  float* z;
  float* r;
  bf16_t* h;
  bf16_t* proj;
  float* gates;
  bf16_t* q;
  bf16_t* k;
  float* sgu_stats;
  bf16_t* hA;
  bf16_t* hB;
  bf16_t* merged;
  bf16_t* qry;
  bf16_t* dC;
  bf16_t* Cin;
  float* dn;
  float* nin;
  float* cscal;
  float* min_;
  int* eidx;
  float* egate;
  unsigned* bar;
};

DEVI int TID() { int t = __builtin_amdgcn_workitem_id_x(); asm volatile("" : "+v"(t)); return t; }
DEVI int BID() { int b = __builtin_amdgcn_workgroup_id_x(); asm volatile("" : "+s"(b)); return b; }
DEVI float bf2f(bf16_t h) { return __uint_as_float(((unsigned)h) << 16); }
typedef __bf16 hwbf2_t __attribute__((ext_vector_type(2)));
typedef float hwf2_t __attribute__((ext_vector_type(2)));
DEVI unsigned pack2(float a, float b) { hwf2_t v = {a, b}; hwbf2_t r = __builtin_convertvector(v, hwbf2_t); return __builtin_bit_cast(unsigned, r); }
DEVI bf16_t f2bf(float f) { return (bf16_t)(pack2(f, f) & 0xFFFFu); }
DEVI float lo2f(unsigned u) { return __uint_as_float(u << 16); }
DEVI float hi2f(unsigned u) { return __uint_as_float(u & 0xFFFF0000u); }
DEVI float frcp(float x) { return __builtin_amdgcn_rcpf(x); }
DEVI float sigmoid_f(float x) { return frcp(1.f + __expf(-x)); }
DEVI float silu_f(float x) { return x * frcp(1.f + __expf(-x)); }
DEVI float gelu_f(float x) { float u = 0.7978845608028654f * (x + 0.044715f * x * x * x); return x * frcp(1.f + __expf(-2.f * u)); }
DEVI float logsigmoid_f(float x) { return fminf(x, 0.f) - log1pf(__expf(-fabsf(x))); }
DEVI uint2 pack4(const f32x4& v) { uint2 o; o.x = pack2(v[0], v[1]); o.y = pack2(v[2], v[3]); return o; }
DEVI f32x4 unpack4(uint2 u) { return f32x4{lo2f(u.x), hi2f(u.x), lo2f(u.y), hi2f(u.y)}; }
DEVI f32x4 sigmoid4(const f32x4& x) { return f32x4{sigmoid_f(x[0]), sigmoid_f(x[1]), sigmoid_f(x[2]), sigmoid_f(x[3])}; }
DEVI int mod_index(int tok) { return tok < 8192 ? 0 : (tok < 16384 ? 1 : 2); }
DEVI int tok_base(int b, int cidx) { return cidx < 64 ? b * 8192 + cidx * 128 : NTX + b * 256 + (cidx - 64) * 128; }
DEVI float wave_sum(float v) {
#pragma unroll
  for (int o = 32; o > 0; o >>= 1) v += __shfl_xor(v, o);
  return v;
}


#define XB_TMO      128
#define XB_XCNT(j)  (256  + 64 * (j))
#define XB_XSUB(j)  (1280 + 64 * (j))
#define XB_XGEN(j)  (2304 + 64 * (j))
#define XB_TOP      3328
#define XB_TOPGEN   3392
#define XCD_BAR_WORDS 3456
#define XB_SPIN_CAP (1u << 20)
#define LAS __attribute__((address_space(3)))
DEVI unsigned xb_ld(unsigned* p) { return __hip_atomic_load(p, __ATOMIC_RELAXED, __HIP_MEMORY_SCOPE_AGENT); }
DEVI unsigned xb_add(unsigned* p, unsigned v) { return __hip_atomic_fetch_add(p, v, __ATOMIC_RELAXED, __HIP_MEMORY_SCOPE_AGENT); }
DEVI unsigned xb_xcc_id() { return (unsigned)__builtin_amdgcn_s_getreg((3 << 11) | 20) & 0xFu; }
#define XB_SPIN(cond, bar) do { unsigned _sp = 0; while (cond) { __builtin_amdgcn_s_sleep(1); \
    if ((++_sp & 255u) == 0u) { if (xb_ld(&(bar)[XB_TMO])) break; if (_sp > XB_SPIN_CAP) { atomicAdd(&(bar)[XB_TMO], 1u); break; } } } } while (0)
struct XcdBarrier { unsigned* bar; unsigned x; volatile LAS unsigned* st; };
DEVI XcdBarrier xcd_barrier_post(unsigned* bar, volatile LAS unsigned* st) {
  XcdBarrier b; b.bar = bar; b.x = xb_xcc_id(); b.st = st;
  if (__builtin_amdgcn_workitem_id_x() == 0) (void)xb_add(&bar[XB_XCNT(b.x)], 1u);
  return b;
}
DEVI void xcd_barrier_complete(unsigned* bar, unsigned x, unsigned& nloc, unsigned& nx) {
  const unsigned G = gridDim.x * gridDim.y * gridDim.z;
  unsigned sum, cnt, mine, sp = 0u;
  for (;;) {
    sum = 0u; cnt = 0u; mine = 0u;
#pragma unroll
    for (unsigned j = 0; j < 16; ++j) { const unsigned c = xb_ld(&bar[XB_XCNT(j)]); sum += c; cnt += (c > 0u) ? 1u : 0u; mine = (j == x) ? c : mine; }
    if (sum == G) break;
    __builtin_amdgcn_s_sleep(1);
    if ((++sp & 255u) == 0u) { if (xb_ld(&bar[XB_TMO])) break; if (sp > XB_SPIN_CAP) { atomicAdd(&bar[XB_TMO], 1u); break; } }
  }
  nloc = mine > 0u ? mine : 1u; nx = cnt > 0u ? cnt : 1u;
}
DEVI void xcd_barrier(const XcdBarrier& b) {
  asm volatile("s_waitcnt vmcnt(0)" ::: "memory");
  __syncthreads();
  if (__builtin_amdgcn_workitem_id_x() == 0) {
    unsigned* bar = b.bar;
    __builtin_amdgcn_s_waitcnt(0);
    unsigned nloc = b.st[0], nx = b.st[1];
    if (nloc == 0u) { xcd_barrier_complete(bar, b.x, nloc, nx); b.st[0] = nloc; b.st[1] = nx; }
    const unsigned old = xb_add(&bar[XB_XSUB(b.x)], 1u);
    const unsigned gen = old / nloc;
    if (old + 1u == (gen + 1u) * nloc) {
      __builtin_amdgcn_fence(__ATOMIC_RELEASE, "agent");
      asm volatile("s_waitcnt vmcnt(0)" ::: "memory");
      const unsigned og = xb_add(&bar[XB_TOP], 1u);
      const unsigned tg = og / nx;
      if (og + 1u == (tg + 1u) * nx) xb_add(&bar[XB_TOPGEN], 1u);
      else XB_SPIN(xb_ld(&bar[XB_TOPGEN]) == tg, bar);
      __builtin_amdgcn_fence(__ATOMIC_ACQUIRE, "agent");
      xb_add(&bar[XB_XGEN(b.x)], 1u);
      asm volatile("s_waitcnt vmcnt(0)" ::: "memory");
    } else {
      XB_SPIN(xb_ld(&bar[XB_XGEN(b.x)]) == gen, bar);
      __builtin_amdgcn_fence(__ATOMIC_ACQUIRE, "agent");
      asm volatile("s_waitcnt vmcnt(0)" ::: "memory");
    }
  }
  __syncthreads();
}

template <int MI, class Epi>
DEVI void gemm_t(const bf16_t* __restrict__ A, const bf16_t* __restrict__ Bt, int m0, int n0, char* smem, Epi epi) {
  const int tid = TID(), lane = tid & 63, wid = tid >> 6, wr = wid >> 1, wc = wid & 1, fr = lane & 15, fq = lane >> 4;
  f32x4 acc[MI][4];
#pragma unroll
  for (int i = 0; i < MI; ++i)
#pragma unroll
    for (int j = 0; j < 4; ++j) acc[i][j] = f32x4{0.f, 0.f, 0.f, 0.f};
  const int srow = tid >> 3, scol = (tid & 7) * 8;
  const bf16_t* ga = A + (size_t)(m0 + srow) * 1024 + scol;
  const bf16_t* gb = Bt + (size_t)(n0 + srow) * 1024 + scol;
  uint4 pa0, pa1, pa2, pa3 = uint4{0, 0, 0, 0}, pb0, pb1, pb2, pb3, qa0, qa1, qa2, qa3 = uint4{0, 0, 0, 0}, qb0, qb1, qb2, qb3;
#define G_LOAD(P, KO) \
  P##a0 = *(const uint4*)(ga + (size_t)0 * 32 * 1024 + (KO)); P##a1 = *(const uint4*)(ga + (size_t)1 * 32 * 1024 + (KO)); \
  P##a2 = *(const uint4*)(ga + (size_t)2 * 32 * 1024 + (KO)); if (MI == 4) P##a3 = *(const uint4*)(ga + (size_t)3 * 32 * 1024 + (KO)); \
  P##b0 = *(const uint4*)(gb + (size_t)0 * 32 * 1024 + (KO)); P##b1 = *(const uint4*)(gb + (size_t)1 * 32 * 1024 + (KO)); \
  P##b2 = *(const uint4*)(gb + (size_t)2 * 32 * 1024 + (KO)); P##b3 = *(const uint4*)(gb + (size_t)3 * 32 * 1024 + (KO));
#define G_STORE(P, BASE) \
  *(uint4*)((BASE) + swoff + 0 * 32 * 144) = P##a0; *(uint4*)((BASE) + swoff + 1 * 32 * 144) = P##a1; \
  *(uint4*)((BASE) + swoff + 2 * 32 * 144) = P##a2; if (MI == 4) *(uint4*)((BASE) + swoff + 3 * 32 * 144) = P##a3; \
  *(uint4*)((BASE) + 18432 + swoff + 0 * 32 * 144) = P##b0; *(uint4*)((BASE) + 18432 + swoff + 1 * 32 * 144) = P##b1; \
  *(uint4*)((BASE) + 18432 + swoff + 2 * 32 * 144) = P##b2; *(uint4*)((BASE) + 18432 + swoff + 3 * 32 * 144) = P##b3;
#define G_COMPUTE(BASE) \
  _Pragma("unroll") for (int ks = 0; ks < 2; ++ks) { \
    bf16x8 a[MI], b[4]; \
    _Pragma("unroll") for (int i = 0; i < MI; ++i) a[i] = *(const bf16x8*)((BASE) + (wr * (MI * 16) + i * 16 + fr) * 144 + ks * 64 + fq * 16); \
    _Pragma("unroll") for (int j = 0; j < 4; ++j) b[j] = *(const bf16x8*)((BASE) + 18432 + (wc * 64 + j * 16 + fr) * 144 + ks * 64 + fq * 16); \
    __builtin_amdgcn_s_setprio(1); \
    _Pragma("unroll") for (int i = 0; i < MI; ++i) \
      _Pragma("unroll") for (int j = 0; j < 4; ++j) acc[i][j] = __builtin_amdgcn_mfma_f32_16x16x32_bf16(b[j], a[i], acc[i][j], 0, 0, 0); \
    __builtin_amdgcn_s_setprio(0); \
  }
  G_LOAD(p, 0)
  const int swoff = srow * 144 + scol * 2;
  __syncthreads();
  G_STORE(p, smem)
  G_LOAD(p, 64)
  __syncthreads();
  for (int kt = 0; kt < 16; kt += 2) {
    const int k2 = (kt + 2 < 16 ? kt + 2 : 15) * 64, k3 = (kt + 3 < 16 ? kt + 3 : 15) * 64;
    G_LOAD(q, k2)
    __builtin_amdgcn_sched_barrier(0);
    G_COMPUTE(smem)
    __builtin_amdgcn_sched_barrier(0);
    G_STORE(p, smem + 36864)
    __syncthreads();
    G_LOAD(p, k3)
    __builtin_amdgcn_sched_barrier(0);
    G_COMPUTE(smem + 36864)
    __builtin_amdgcn_sched_barrier(0);
    G_STORE(q, smem)
    __syncthreads();
  }
#undef G_LOAD
#undef G_STORE
#undef G_COMPUTE
#pragma unroll
  for (int i = 0; i < MI; ++i)
#pragma unroll
    for (int j = 0; j < 4; ++j) epi(m0 + wr * (MI * 16) + i * 16 + fr, n0 + wc * 64 + j * 16 + fq * 4, acc[i][j]);
}

#define LDS3 __attribute__((address_space(3)))
template <class Epi>
DEVI void gemm128g(const bf16_t* __restrict__ A, const bf16_t* __restrict__ Bt, int m0, int n0, char* smem, Epi epi) {
  const int tid = TID(), lane = tid & 63, wid = __builtin_amdgcn_readfirstlane(tid >> 6), wr = wid >> 1, wc = wid & 1, fr = lane & 15, fq = lane >> 4;
  f32x4 acc[4][4];
#pragma unroll
  for (int i = 0; i < 4; ++i)
#pragma unroll
    for (int j = 0; j < 4; ++j) acc[i][j] = f32x4{0.f, 0.f, 0.f, 0.f};
  const int rr = lane >> 2, cchunk = (lane & 3) ^ ((0x78 >> (2 * ((rr >> 2) & 3))) & 3);
  const bf16_t* gA0 = A + (size_t)(m0 + wid * 32 + rr) * 1024 + cchunk * 8;
  const bf16_t* gB0 = Bt + (size_t)(n0 + wid * 32 + rr) * 1024 + cchunk * 8;
  const int segA = wid * 2048, segB = 8192 + wid * 2048;
#define GL_ISSUE(KT) { const int s_ = ((KT) & 3) * 16384; const int ko_ = ((KT) < 31 ? (KT) : 31) * 32; \
    __builtin_amdgcn_global_load_lds((const unsigned*)(gA0 + ko_), (LDS3 unsigned*)(smem + s_ + segA), 16, 0, 0); \
    __builtin_amdgcn_global_load_lds((const unsigned*)(gA0 + ko_ + 16 * 1024), (LDS3 unsigned*)(smem + s_ + segA + 1024), 16, 0, 0); \
    __builtin_amdgcn_global_load_lds((const unsigned*)(gB0 + ko_), (LDS3 unsigned*)(smem + s_ + segB), 16, 0, 0); \
    __builtin_amdgcn_global_load_lds((const unsigned*)(gB0 + ko_ + 16 * 1024), (LDS3 unsigned*)(smem + s_ + segB + 1024), 16, 0, 0); }
  const int swz = (0x78 >> (2 * ((fr >> 2) & 3))) & 3;
  const int rdA = (wr * 64 + fr) * 64 + ((fq ^ swz) * 16);
  const int rdB = 8192 + (wc * 64 + fr) * 64 + ((fq ^ swz) * 16);
  __syncthreads();
  GL_ISSUE(0) GL_ISSUE(1) GL_ISSUE(2)
#pragma unroll 1
  for (int kt = 0; kt < 32; ++kt) {
    asm volatile("s_waitcnt vmcnt(8)" ::: "memory");
    __builtin_amdgcn_s_barrier();
    GL_ISSUE(kt + 3)
    const char* st = smem + (kt & 3) * 16384;
    bf16x8 a[4], b[4];
#pragma unroll
    for (int i = 0; i < 4; ++i) a[i] = *(const bf16x8*)(st + rdA + i * 1024);
#pragma unroll
    for (int j = 0; j < 4; ++j) b[j] = *(const bf16x8*)(st + rdB + j * 1024);
    __builtin_amdgcn_s_setprio(1);
#pragma unroll
    for (int i = 0; i < 4; ++i)
#pragma unroll
      for (int j = 0; j < 4; ++j) acc[i][j] = __builtin_amdgcn_mfma_f32_16x16x32_bf16(b[j], a[i], acc[i][j], 0, 0, 0);
    __builtin_amdgcn_s_setprio(0);
  }
  asm volatile("s_waitcnt vmcnt(0)" ::: "memory");
  __syncthreads();
#undef GL_ISSUE
#pragma unroll
  for (int i = 0; i < 4; ++i)
#pragma unroll
    for (int j = 0; j < 4; ++j) epi(m0 + wr * 64 + i * 16 + fr, n0 + wc * 64 + j * 16 + fq * 4, acc[i][j]);
}

template <class Epi>
DEVI void gemm256g(const bf16_t* __restrict__ A, const bf16_t* __restrict__ Bt, int m0, int n0, char* smem, Epi epi,
                    bf16_t* __restrict__ sout = nullptr, int ldo = 0, int n_staged = 0) {
  const int tid = TID(), lane = tid & 63, wid = __builtin_amdgcn_readfirstlane(tid >> 6), wr = wid >> 1, wc = wid & 1, fr = lane & 15, fq = lane >> 4;
  f32x4 acc[8][4];
#pragma unroll
  for (int i = 0; i < 8; ++i)
#pragma unroll
    for (int j = 0; j < 4; ++j) acc[i][j] = f32x4{0.f, 0.f, 0.f, 0.f};
  const int rr = lane >> 2, cchunk = (lane & 3) ^ ((0x78 >> (2 * ((rr >> 2) & 3))) & 3);
  const bf16_t* gA0 = A + (size_t)(m0 + wid * 64 + rr) * 1024 + cchunk * 8;
  const bf16_t* gB0 = Bt + (size_t)(n0 + wid * 32 + rr) * 1024 + cchunk * 8;
  const int segA = wid * 4096, segB = 16384 + wid * 2048;
#define GL2_ISSUE(KT, ST) { const int s_ = (ST) * 24576; const int ko_ = ((KT) < 31 ? (KT) : 31) * 32; \
    __builtin_amdgcn_global_load_lds((const unsigned*)(gA0 + ko_), (LDS3 unsigned*)(smem + s_ + segA), 16, 0, 0); \
    __builtin_amdgcn_global_load_lds((const unsigned*)(gA0 + ko_ + 16 * 1024), (LDS3 unsigned*)(smem + s_ + segA + 1024), 16, 0, 0); \
    __builtin_amdgcn_global_load_lds((const unsigned*)(gA0 + ko_ + 32 * 1024), (LDS3 unsigned*)(smem + s_ + segA + 2048), 16, 0, 0); \
    __builtin_amdgcn_global_load_lds((const unsigned*)(gA0 + ko_ + 48 * 1024), (LDS3 unsigned*)(smem + s_ + segA + 3072), 16, 0, 0); \
    __builtin_amdgcn_global_load_lds((const unsigned*)(gB0 + ko_), (LDS3 unsigned*)(smem + s_ + segB), 16, 0, 0); \
    __builtin_amdgcn_global_load_lds((const unsigned*)(gB0 + ko_ + 16 * 1024), (LDS3 unsigned*)(smem + s_ + segB + 1024), 16, 0, 0); }
  const int swz = (0x78 >> (2 * ((fr >> 2) & 3))) & 3;
  const int rdA = (wr * 128 + fr) * 64 + ((fq ^ swz) * 16);
  const int rdB = 16384 + (wc * 64 + fr) * 64 + ((fq ^ swz) * 16);
  __syncthreads();
  GL2_ISSUE(0, 0) GL2_ISSUE(1, 1)
  int stc = 0;
#pragma unroll 1
  for (int kt = 0; kt < 32; ++kt) {
    asm volatile("s_waitcnt vmcnt(6)" ::: "memory");
    __builtin_amdgcn_s_barrier();
    { const int stn = stc == 0 ? 2 : stc - 1; GL2_ISSUE(kt + 2, stn) }
    const char* st = smem + stc * 24576;
    bf16x8 b[4];
#pragma unroll
    for (int j = 0; j < 4; ++j) b[j] = *(const bf16x8*)(st + rdB + j * 1024);
    __builtin_amdgcn_s_setprio(1);
#pragma unroll
    for (int i = 0; i < 8; ++i) {
      bf16x8 a = *(const bf16x8*)(st + rdA + i * 1024);
#pragma unroll
      for (int j = 0; j < 4; ++j) acc[i][j] = __builtin_amdgcn_mfma_f32_16x16x32_bf16(b[j], a, acc[i][j], 0, 0, 0);
    }
    __builtin_amdgcn_s_setprio(0);
    stc = stc == 2 ? 0 : stc + 1;
  }
  asm volatile("s_waitcnt vmcnt(0)" ::: "memory");
  __syncthreads();
#undef GL2_ISSUE
  if (sout != nullptr && n0 < n_staged) {
#pragma unroll
    for (int i = 0; i < 8; ++i)
#pragma unroll
      for (int j = 0; j < 4; ++j) *(uint2*)(smem + (wr * 128 + i * 16 + fr) * 272 + (wc * 64 + j * 16 + fq * 4) * 2) = pack4(acc[i][j]);
    __syncthreads();
#pragma unroll 4
    for (int it = 0; it < 16; ++it) {
      const int c = tid + it * 256, row = c >> 4, c16 = c & 15;
      *(uint4*)(sout + (size_t)(m0 + row) * ldo + n0 + c16 * 8) = *(const uint4*)(smem + row * 272 + c16 * 16);
    }
    return;
  }
#pragma unroll
  for (int i = 0; i < 8; ++i)
#pragma unroll
    for (int j = 0; j < 4; ++j) epi(m0 + wr * 128 + i * 16 + fr, n0 + wc * 64 + j * 16 + fq * 4, acc[i][j]);
}

template <class Epi>
DEVI void gemm128(const bf16_t* __restrict__ A, const bf16_t* __restrict__ Bt, int m0, int n0, char* smem, Epi epi) { gemm_t<4>(A, Bt, m0, n0, smem, epi); }
template <class Epi>
DEVI void gemm96(const bf16_t* __restrict__ A, const bf16_t* __restrict__ Bt, int m0, int n0, char* smem, Epi epi) { gemm_t<3>(A, Bt, m0, n0, smem, epi); }

DEVI void transpose_tile(const float* __restrict__ src, int N, int k0, int n0, bf16_t* __restrict__ dst, int dstrow0, char* smem) {
  float* t = (float*)smem;
  const int tid = TID();
  __syncthreads();
#pragma unroll
  for (int i = 0; i < 8; ++i) {
    int kk = (tid >> 5) + i * 8, nn = tid & 31;
    t[kk * 33 + nn] = src[(size_t)(k0 + kk) * N + n0 + nn];
  }
  __syncthreads();
  int nn = tid >> 3, ks = (tid & 7) * 8;
  float v[8];
#pragma unroll
  for (int j = 0; j < 8; ++j) v[j] = t[(ks + j) * 33 + nn];
  uint4 o;
  o.x = pack2(v[0], v[1]); o.y = pack2(v[2], v[3]); o.z = pack2(v[4], v[5]); o.w = pack2(v[6], v[7]);
  *(uint4*)(dst + (size_t)(dstrow0 + nn) * 1024 + k0 + ks) = o;
}

struct Tile8 { uint4 v0, v1, v2, v3, v4, v5, v6, v7; };
DEVI Tile8 tile_load(const bf16_t* __restrict__ src, int ld, int tid) {
  Tile8 t;
  const bf16_t* s0 = src + (size_t)(tid >> 4) * ld + (tid & 15) * 8;
  t.v0 = *(const uint4*)(s0); t.v1 = *(const uint4*)(s0 + (size_t)16 * ld); t.v2 = *(const uint4*)(s0 + (size_t)32 * ld); t.v3 = *(const uint4*)(s0 + (size_t)48 * ld);
  t.v4 = *(const uint4*)(s0 + (size_t)64 * ld); t.v5 = *(const uint4*)(s0 + (size_t)80 * ld); t.v6 = *(const uint4*)(s0 + (size_t)96 * ld); t.v7 = *(const uint4*)(s0 + (size_t)112 * ld);
  return t;
}
DEVI void tile_put_T1(bf16_t* dst, const uint4& u, int row, int c8, const float* scale) {
  unsigned w[4] = {u.x, u.y, u.z, u.w};
  if (scale) {
    float s = scale[row];
#pragma unroll
    for (int j = 0; j < 4; ++j) {
      dst[(c8 + 2 * j) * 136 + row] = f2bf(lo2f(w[j]) * s);
      dst[(c8 + 2 * j + 1) * 136 + row] = f2bf(hi2f(w[j]) * s);
    }
  } else {
#pragma unroll
    for (int j = 0; j < 4; ++j) {
      dst[(c8 + 2 * j) * 136 + row] = (bf16_t)(w[j] & 0xFFFF);
      dst[(c8 + 2 * j + 1) * 136 + row] = (bf16_t)(w[j] >> 16);
    }
  }
}
DEVI void tile_put_T(char* dstb, const Tile8& t, int tid, const float* scale) {
  bf16_t* dst = (bf16_t*)dstb;
  const int row = tid >> 4, c8 = (tid & 15) * 8;
  tile_put_T1(dst, t.v0, row, c8, scale); tile_put_T1(dst, t.v1, row + 16, c8, scale); tile_put_T1(dst, t.v2, row + 32, c8, scale); tile_put_T1(dst, t.v3, row + 48, c8, scale);
  tile_put_T1(dst, t.v4, row + 64, c8, scale); tile_put_T1(dst, t.v5, row + 80, c8, scale); tile_put_T1(dst, t.v6, row + 96, c8, scale); tile_put_T1(dst, t.v7, row + 112, c8, scale);
}
struct TileT { uint4 a0, a1, a2, a3, b0, b1, b2, b3; };
DEVI TileT tile_loadT(const bf16_t* __restrict__ src, int ld, int tid) {
  TileT t;
  const bf16_t* s0 = src + (size_t)((tid & 63) * 2) * ld + (tid >> 6) * 32;
  const bf16_t* s1 = s0 + ld;
  t.a0 = *(const uint4*)(s0); t.a1 = *(const uint4*)(s0 + 8); t.a2 = *(const uint4*)(s0 + 16); t.a3 = *(const uint4*)(s0 + 24);
  t.b0 = *(const uint4*)(s1); t.b1 = *(const uint4*)(s1 + 8); t.b2 = *(const uint4*)(s1 + 16); t.b3 = *(const uint4*)(s1 + 24);
  return t;
}
DEVI void tile_putT_chunk(unsigned* dst, const uint4& ua, const uint4& ub, int cbase, int rp, bool scaled, float sa, float sb) {
  const unsigned wa[4] = {ua.x, ua.y, ua.z, ua.w}, wb[4] = {ub.x, ub.y, ub.z, ub.w};
#pragma unroll
  for (int k = 0; k < 4; ++k) {
    unsigned lo, hi;
    if (scaled) { lo = pack2(lo2f(wa[k]) * sa, lo2f(wb[k]) * sb); hi = pack2(hi2f(wa[k]) * sa, hi2f(wb[k]) * sb); }
    else { lo = (wa[k] & 0xFFFFu) | (wb[k] << 16); hi = (wa[k] >> 16) | (wb[k] & 0xFFFF0000u); }
    dst[(cbase + 2 * k) * 68 + rp] = lo;
    dst[(cbase + 2 * k + 1) * 68 + rp] = hi;
  }
}
DEVI void tile_putT2(char* dstb, const TileT& t, int tid, const float* scale) {
  unsigned* dst = (unsigned*)dstb;
  const int rp = tid & 63, c0 = (tid >> 6) * 32;
  const bool scaled = scale != nullptr;
  float sa = 1.f, sb = 1.f;
  if (scaled) { sa = scale[2 * rp]; sb = scale[2 * rp + 1]; }
  tile_putT_chunk(dst, t.a0, t.b0, c0, rp, scaled, sa, sb);
  tile_putT_chunk(dst, t.a1, t.b1, c0 + 8, rp, scaled, sa, sb);
  tile_putT_chunk(dst, t.a2, t.b2, c0 + 16, rp, scaled, sa, sb);
  tile_putT_chunk(dst, t.a3, t.b3, c0 + 24, rp, scaled, sa, sb);
}
DEVI void tile_put_R(char* dstb, const Tile8& t, int tid) {
  char* d = dstb + (tid >> 4) * 272 + (tid & 15) * 16;
  *(uint4*)(d) = t.v0; *(uint4*)(d + 16 * 272) = t.v1; *(uint4*)(d + 32 * 272) = t.v2; *(uint4*)(d + 48 * 272) = t.v3;
  *(uint4*)(d + 64 * 272) = t.v4; *(uint4*)(d + 80 * 272) = t.v5; *(uint4*)(d + 96 * 272) = t.v6; *(uint4*)(d + 112 * 272) = t.v7;
}
DEVI void stage_T(char* dstb, const bf16_t* __restrict__ src, int ld, const float* scale) {
  const int tid = TID();
  Tile8 t = tile_load(src, ld, tid);
  tile_put_T(dstb, t, tid, scale);
}
DEVI void stage_R(char* dstb, const bf16_t* __restrict__ src, int ld) {
  const int tid = TID();
  Tile8 t = tile_load(src, ld, tid);
  tile_put_R(dstb, t, tid);
}

DEVI void mma_regA(const bf16x8 (&a)[2][4], const char* B, f32x4 (&acc)[2][8], int fr, int fq) {
#pragma unroll
  for (int ks = 0; ks < 4; ++ks) {
#pragma unroll
    for (int nt = 0; nt < 8; ++nt) {
      bf16x8 b = *(const bf16x8*)(B + (nt * 16 + fr) * 272 + ks * 64 + fq * 16);
#pragma unroll
      for (int mt = 0; mt < 2; ++mt) acc[mt][nt] = __builtin_amdgcn_mfma_f32_16x16x32_bf16(b, a[mt][ks], acc[mt][nt], 0, 0, 0);
    }
    asm volatile("" ::: "memory");
  }
}
DEVI void load_fragA(bf16x8 (&a)[2][4], const char* A, int rowbase, int fr, int fq) {
#pragma unroll
  for (int mt = 0; mt < 2; ++mt)
#pragma unroll
    for (int ks = 0; ks < 4; ++ks) a[mt][ks] = *(const bf16x8*)(A + (rowbase + mt * 16 + fr) * 272 + ks * 64 + fq * 16);
}

DEVI void phase_mod(const Params& p, char* smem) {
  float* s = (float*)smem;
  float* red = s + 3072;
  const int tid = TID();
  for (int i = tid; i < 1024; i += 256) {
    s[i] = silu_f(p.c[i]);
    s[1024 + i] = silu_f(p.c[1024 + i]);
    s[2048 + i] = silu_f(p.c_ctx[i]);
  }
  __syncthreads();
  const int kg = tid >> 6, col = tid & 63;
  for (int item = BID(); item < 4 * 96; item += gridDim.x) {
    int l = item / 96, cb = item % 96, n = cb * 64 + col;
    const float* W = p.w_mod + (size_t)l * 1024 * 6144 + n;
    float a0 = 0, a1 = 0, a2 = 0;
#pragma unroll 32
    for (int k = kg * 256; k < kg * 256 + 256; ++k) {
      float w = W[(size_t)k * 6144];
      a0 += s[k] * w; a1 += s[1024 + k] * w; a2 += s[2048 + k] * w;
    }
    red[(kg * 3 + 0) * 64 + col] = a0; red[(kg * 3 + 1) * 64 + col] = a1; red[(kg * 3 + 2) * 64 + col] = a2;
    __syncthreads();
    if (tid < 192) {
      int i = tid >> 6;
      float v = red[(0 * 3 + i) * 64 + col] + red[(1 * 3 + i) * 64 + col] + red[(2 * 3 + i) * 64 + col] + red[(3 * 3 + i) * 64 + col];
      p.mod[((size_t)l * 3 + i) * 6144 + n] = v + p.b_mod[l * 6144 + n];
    }
    __syncthreads();
  }
}

DEVI void phase_prep(const Params& p, int l, char* smem) {
  const int tid = TID();
  const int n_in = 257 * 16, n_sq = 32 * 16, n_q = 64 * 16;
  const int total = n_in + 3 * n_sq + n_q;
  for (int item = BID(); item < total; item += gridDim.x) {
    int it = item;
    if (it < n_in) {
      int nt = it >> 4, kt = it & 15, n0 = nt * 32;
      int d0 = n0 < 4096 ? n0 : (n0 < 4128 ? n0 + 4096 : n0 - 32);
      transpose_tile(p.w_in + (size_t)l * 1024 * INW, INW, kt * 64, n0, p.wt_in, d0, smem);
    } else if ((it -= n_in) < 3 * n_sq) {
      int which = it / n_sq; it %= n_sq;
      int nt = it >> 4, kt = it & 15;
      const float* src = (which == 0 ? p.p_a : which == 1 ? p.p_b : p.w_out) + (size_t)l * 1024 * 1024;
      bf16_t* dst = which == 0 ? p.wt_pa : which == 1 ? p.wt_pb : p.wt_out;
      transpose_tile(src, 1024, kt * 64, nt * 32, dst, nt * 32, smem);
    } else {
      it -= 3 * n_sq;
      int nt = it >> 4, kt = it & 15;
      transpose_tile(p.peer_wq + (size_t)l * 1024 * 2048, 2048, kt * 64, nt * 32, p.wt_q, nt * 32, smem);
    }
  }
  const size_t gtid = (size_t)BID() * 256 + tid, gstride = (size_t)gridDim.x * 256;
  for (size_t i = gtid; i < (size_t)(INWP - INW) * 1024 / 8; i += gstride) ((uint4*)(p.wt_in + (size_t)INW * 1024))[i] = uint4{0, 0, 0, 0};
  {
    const int lane = tid & 63;
    const int gw = (int)(gtid >> 6), nw = (int)(gstride >> 6);
    for (int row = gw; row < 32768; row += nw) {
      const int e = row & 16383, which = row >> 14;
      const float* src = (which ? p.expert_v : p.expert_u) + ((size_t)l * 16384 + e) * 1024 + lane * 16;
      float4 a0 = *(const float4*)(src), a1 = *(const float4*)(src + 4), a2 = *(const float4*)(src + 8), a3 = *(const float4*)(src + 12);
      float am = fmaxf(fmaxf(fmaxf(fabsf(a0.x), fabsf(a0.y)), fmaxf(fabsf(a0.z), fabsf(a0.w))), fmaxf(fmaxf(fabsf(a1.x), fabsf(a1.y)), fmaxf(fabsf(a1.z), fabsf(a1.w))));
      am = fmaxf(am, fmaxf(fmaxf(fmaxf(fabsf(a2.x), fabsf(a2.y)), fmaxf(fabsf(a2.z), fabsf(a2.w))), fmaxf(fmaxf(fabsf(a3.x), fabsf(a3.y)), fmaxf(fabsf(a3.z), fabsf(a3.w)))));
#pragma unroll
      for (int o = 32; o > 0; o >>= 1) am = fmaxf(am, __shfl_xor(am, o));
      const float sc = am > 0.f ? am * (1.f / 440.f) : 1.f, inv = 1.f / sc;
      int w0 = 0, w1 = 0, w2 = 0, w3 = 0;
      w0 = __builtin_amdgcn_cvt_pk_fp8_f32(a0.x * inv, a0.y * inv, w0, false); w0 = __builtin_amdgcn_cvt_pk_fp8_f32(a0.z * inv, a0.w * inv, w0, true);
      w1 = __builtin_amdgcn_cvt_pk_fp8_f32(a1.x * inv, a1.y * inv, w1, false); w1 = __builtin_amdgcn_cvt_pk_fp8_f32(a1.z * inv, a1.w * inv, w1, true);
      w2 = __builtin_amdgcn_cvt_pk_fp8_f32(a2.x * inv, a2.y * inv, w2, false); w2 = __builtin_amdgcn_cvt_pk_fp8_f32(a2.z * inv, a2.w * inv, w2, true);
      w3 = __builtin_amdgcn_cvt_pk_fp8_f32(a3.x * inv, a3.y * inv, w3, false); w3 = __builtin_amdgcn_cvt_pk_fp8_f32(a3.z * inv, a3.w * inv, w3, true);
      unsigned char* dst = (which ? p.ev : p.eu) + (size_t)(l & 1) * 16384 * 1024 + (size_t)e * 1024 + lane * 16;
      *(uint4*)dst = uint4{(unsigned)w0, (unsigned)w1, (unsigned)w2, (unsigned)w3};
      if (lane == 0) p.escale[(l & 1) * 32768 + which * 16384 + e] = sc;
    }
  }
  {
    const float* sk = p.peer_keys + (size_t)l * 262144;
    for (size_t i = gtid; i < 262144; i += gstride) p.keys[(size_t)(l & 1) * 262144 + i] = f2bf(sk[i]);
  }
  if (l == 0) {
    for (size_t i = gtid; i < (size_t)NT * 256; i += gstride) {
      int tok = (int)(i >> 8), d = (int)(i & 255) * 4;
      float4 v = tok < NTX ? *(const float4*)(p.x + (size_t)tok * 1024 + d) : *(const float4*)(p.ctx + (size_t)(tok - NTX) * 1024 + d);
      *(float4*)(p.z + (size_t)tok * 1024 + d) = v;
      const float* m = p.mod + (size_t)mod_index(tok) * 6144;
      float h0 = v.x * (1.f + m[1024 + d]) + m[d], h1 = v.y * (1.f + m[1024 + d + 1]) + m[d + 1];
      float h2 = v.z * (1.f + m[1024 + d + 2]) + m[d + 2], h3 = v.w * (1.f + m[1024 + d + 3]) + m[d + 3];
      uint2 o; o.x = pack2(h0, h1); o.y = pack2(h2, h3);
      *(uint2*)(p.h + (size_t)tok * 1024 + d) = o;
    }
  }
}

DEVI bool xcd_tile(int it, int nM, int nN, int& mt, int& nt) {
  const int b = BID(), per = gridDim.x >> 3;
  const int t = (it * 8 + (b & 7)) * per + (b >> 3);
  if (t >= nM * nN) return false;
  const int width = 8 * nN, g = t / width, first_m = g * 8;
  const int gsz = min(nM - first_m, 8), tt = t - g * width;
  mt = first_m + tt % gsz; nt = tt / gsz;
  return true;
}

DEVI void phase_g1(const Params& p, int l, char* smem) {
  const int nM256 = 63, nM128 = (NT - 63 * 256) / 128, nN = INWP / 128;
  bf16_t* proj = p.proj; float* gates = p.gates; const float* gate_b = p.gate_b + l * 32;
  auto epi = [&](int m, int n, const f32x4& v) {
    if (n < 8192) *(uint2*)(proj + (size_t)m * 8192 + n) = pack4(v);
    else if (n < 8224) *(f32x4*)(gates + m * 32 + (n - 8192)) = v + *(const f32x4*)(gate_b + (n - 8192));
  };
  for (int it = 0;; ++it) {
    int mt, nt;
    if (!xcd_tile(it, nM256, nN, mt, nt)) break;
    gemm256g(p.h, p.wt_in, mt * 256, nt * 128, smem, epi, proj, 8192, 8192);
  }
  for (int it = 0;; ++it) {
    int mt, nt;
    if (!xcd_tile(it, nM128, nN, mt, nt)) break;
    gemm128g(p.h, p.wt_in, nM256 * 256 + mt * 128, nt * 128, smem, epi);
  }
}

DEVI void conv_tap(float (&acc)[8], const uint4& u, const float4& w0, const float4& w1) {
  acc[0] += lo2f(u.x) * w0.x; acc[1] += hi2f(u.x) * w0.y; acc[2] += lo2f(u.y) * w0.z; acc[3] += hi2f(u.y) * w0.w;
  acc[4] += lo2f(u.z) * w1.x; acc[5] += hi2f(u.z) * w1.y; acc[6] += lo2f(u.w) * w1.z; acc[7] += hi2f(u.w) * w1.w;
}
DEVI void phase_conv(const Params& p, int l, char* smem) {
  const int tid = TID();
  const size_t gtid = (size_t)BID() * 256 + tid, gstride = (size_t)gridDim.x * 256;
  const float* cw = p.qk_conv_w + (size_t)l * 9 * 2048;
  const float* cb = p.qk_conv_b + (size_t)l * 2048;
  const bf16_t* __restrict__ proj = p.proj;
  for (size_t i = gtid; i < (size_t)256 * 2 * 256; i += gstride) {
    const int cg = (int)(i & 255), seg = (int)((i >> 8) & 1), grow = (int)(i >> 9), b = grow >> 7, r = grow & 127, ch = cg * 8;
    float4 w[9][2];
#pragma unroll
    for (int t = 0; t < 9; ++t) { w[t][0] = *(const float4*)(cw + t * 2048 + ch); w[t][1] = *(const float4*)(cw + t * 2048 + ch + 4); }
    const float4 b0 = *(const float4*)(cb + ch), b1 = *(const float4*)(cb + ch + 4);
    const bool v0 = r > 0, v2 = r < 127;
    const bf16_t* row1 = proj + (size_t)(b * 8192 + r * 64) * 8192 + ch;
    const bf16_t* row0 = row1 - (size_t)64 * 8192;
    const bf16_t* row2 = row1 + (size_t)64 * 8192;
    const uint4 zz = uint4{0, 0, 0, 0};
    const int c0 = seg * 32;
    uint4 L0 = zz, L1 = zz, L2 = zz, M0, M1, M2;
    if (c0 > 0) {
      L0 = v0 ? *(const uint4*)(row0 + (size_t)(c0 - 1) * 8192) : zz;
      L1 = *(const uint4*)(row1 + (size_t)(c0 - 1) * 8192);
      L2 = v2 ? *(const uint4*)(row2 + (size_t)(c0 - 1) * 8192) : zz;
    }
    M0 = v0 ? *(const uint4*)(row0 + (size_t)c0 * 8192) : zz;
    M1 = *(const uint4*)(row1 + (size_t)c0 * 8192);
    M2 = v2 ? *(const uint4*)(row2 + (size_t)c0 * 8192) : zz;
    const float sc = ch < 1024 ? 0.08838834764831845f : 1.f;
    bf16_t* dst = (ch < 1024 ? p.q + ch : p.k + (ch - 1024)) + (size_t)(b * 8192 + r * 64) * 1024;
#pragma unroll 1
    for (int cc = c0; cc < c0 + 32; cc += 4) {
      uint4 R0[4], R1[4], R2[4];
#pragma unroll
      for (int j = 0; j < 4; ++j) {
        const int cn = cc + j + 1;
        const bool vc = cn < 64;
        R0[j] = (vc && v0) ? *(const uint4*)(row0 + (size_t)cn * 8192) : zz;
        R1[j] = vc ? *(const uint4*)(row1 + (size_t)cn * 8192) : zz;
        R2[j] = (vc && v2) ? *(const uint4*)(row2 + (size_t)cn * 8192) : zz;
      }
#pragma unroll
      for (int j = 0; j < 4; ++j) {
        float acc[8] = {b0.x, b0.y, b0.z, b0.w, b1.x, b1.y, b1.z, b1.w};
        conv_tap(acc, L0, w[0][0], w[0][1]); conv_tap(acc, M0, w[1][0], w[1][1]); conv_tap(acc, R0[j], w[2][0], w[2][1]);
        conv_tap(acc, L1, w[3][0], w[3][1]); conv_tap(acc, M1, w[4][0], w[4][1]); conv_tap(acc, R1[j], w[5][0], w[5][1]);
        conv_tap(acc, L2, w[6][0], w[6][1]); conv_tap(acc, M2, w[7][0], w[7][1]); conv_tap(acc, R2[j], w[8][0], w[8][1]);
#pragma unroll
        for (int q = 0; q < 8; ++q) acc[q] = silu_f(acc[q]) * sc;
        uint4 o; o.x = pack2(acc[0], acc[1]); o.y = pack2(acc[2], acc[3]); o.z = pack2(acc[4], acc[5]); o.w = pack2(acc[6], acc[7]);
        *(uint4*)(dst + (size_t)(cc + j) * 1024) = o;
        L0 = M0; L1 = M1; L2 = M2; M0 = R0[j]; M1 = R1[j]; M2 = R2[j];
      }
    }
  }
  for (size_t i = (size_t)NTX * 256 + gtid; i < (size_t)NT * 256; i += gstride) {
    int tok = (int)(i >> 8), ch = (int)(i & 255) * 8;
    float acc[8];
#pragma unroll
    for (int j = 0; j < 8; ++j) acc[j] = cb[ch + j];
    int t = (tok - NTX) & 255;
#pragma unroll
    for (int dj = 0; dj < 3; ++dj) {
      int tt = t + dj - 1;
      if (tt >= 0 && tt < 256) {
        uint4 u = *(const uint4*)(p.proj + (size_t)(tok + dj - 1) * 8192 + ch);
        const float* w = cw + (3 + dj) * 2048 + ch;
        conv_tap(acc, u, *(const float4*)w, *(const float4*)(w + 4));
      }
    }
    float sc = ch < 1024 ? 0.08838834764831845f : 1.f;
#pragma unroll
    for (int j = 0; j < 8; ++j) acc[j] = silu_f(acc[j]) * sc;
    uint4 o; o.x = pack2(acc[0], acc[1]); o.y = pack2(acc[2], acc[3]); o.z = pack2(acc[4], acc[5]); o.w = pack2(acc[6], acc[7]);
    if (ch < 1024) *(uint4*)(p.q + (size_t)tok * 1024 + ch) = o;
    else *(uint4*)(p.k + (size_t)tok * 1024 + ch - 1024) = o;
  }
  const int lane = tid & 63;
  const int gw = (BID() * 256 + tid) >> 6, nw = gridDim.x * 4;
  for (int tok = gw; tok < NT; tok += nw) {
    const bf16_t* src = p.proj + (size_t)tok * 8192 + 5120;
    uint4 u0 = *(const uint4*)(src + lane * 8), u1 = *(const uint4*)(src + 512 + lane * 8);
    unsigned w[8] = {u0.x, u0.y, u0.z, u0.w, u1.x, u1.y, u1.z, u1.w};
    float g[16]; float s = 0.f;
#pragma unroll
    for (int j = 0; j < 8; ++j) { g[2 * j] = gelu_f(lo2f(w[j])); g[2 * j + 1] = gelu_f(hi2f(w[j])); s += g[2 * j] + g[2 * j + 1]; }
    float mu = wave_sum(s) * (1.f / 1024.f);
    float v = 0.f;
#pragma unroll
    for (int j = 0; j < 16; ++j) { float d = g[j] - mu; v += d * d; }
    v = wave_sum(v) * (1.f / 1024.f);
    if (lane == 0) { p.sgu_stats[tok * 2] = mu; p.sgu_stats[tok * 2 + 1] = rsqrtf(v + LN_EPS); }
  }
}

DEVI void store_acc_bf16(bf16_t* dst, const f32x4 (&acc)[2][8], int rowbase, int fr, int fq) {
#pragma unroll
  for (int mt = 0; mt < 2; ++mt)
#pragma unroll
    for (int nt = 0; nt < 8; ++nt) *(uint2*)(dst + (rowbase + mt * 16 + fr) * 128 + nt * 16 + fq * 4) = pack4(acc[mt][nt]);
}

DEVI void mloc_item(const Params& p, int item, char* smem) {
  int tid_ = TID(); asm volatile("" : "+v"(tid_));
  const int tid = tid_, lane = tid & 63, wid = tid >> 6, fr = lane & 15, fq = lane >> 4;
  const int cidx = item % 66, bh = item / 66, hh = bh & 7, b = bh >> 3;
  const int tok0 = tok_base(b, cidx);
  char* KT = smem; char* VT = smem + 34816;
  float* fa = (float*)(smem + 69632);
  float *fcf = fa, *fif = fa + 128, *fcb = fa + 256, *fib = fa + 384, *bf = fa + 512, *bb = fa + 640, *wlf = fa + 768, *wlb = fa + 896;
  __syncthreads();
  if (tid < 128) {
    const float* g = p.gates + (size_t)(tok0 + tid) * 32;
    fif[tid] = g[hh]; fcf[tid] = logsigmoid_f(g[8 + hh]); fib[tid] = g[16 + hh]; fcb[tid] = logsigmoid_f(g[24 + hh]);
  }
  __syncthreads();
  if (tid < 128) { float s = 0.f;
#pragma unroll 8
    for (int i = 0; i <= tid; ++i) s += fcf[i]; bf[tid] = s; }
  else { int t = tid - 128; float s = 0.f;
#pragma unroll 8
    for (int i = 127; i >= t; --i) s += fcb[i]; bb[t] = s; }
  __syncthreads();
  float gf = bf[127], gb = bb[0], mlf, mlb;
  {
    float m = -3.0e38f;
    if (tid < 128) {
_Pragma("unroll 4")
 for (int i = 0; i < 128; ++i) m = fmaxf(m, gf - bf[i] + fif[i]); wlf[tid] = __expf(gf - bf[tid] + fif[tid] - m); mlf = m; }
    else { int t = tid - 128;
_Pragma("unroll 4")
 for (int i = 0; i < 128; ++i) m = fmaxf(m, gb - bb[i] + fib[i]); wlb[t] = __expf(gb - bb[t] + fib[t] - m); mlb = m; }
  }
  if (tid == 0) { p.cscal[(0 * NITEM + item) * 2] = gf; p.cscal[(0 * NITEM + item) * 2 + 1] = mlf; }
  if (tid == 128) { p.cscal[(1 * NITEM + item) * 2] = gb; p.cscal[(1 * NITEM + item) * 2 + 1] = mlb; }
  __syncthreads();
  const bf16_t* ksrc = p.k + (size_t)tok0 * 1024 + hh * 128;
  const bf16_t* vsrc = p.proj + (size_t)tok0 * 8192 + 2048 + hh * 128;
  {
    TileT tk = tile_loadT(ksrc, 1024, tid);
    tile_putT2(KT, tk, tid, nullptr);
  }
#pragma unroll 1
  for (int dir = 0; dir < 2; ++dir) {
    const float* wl = dir ? wlb : wlf;
    {
      TileT tv = tile_loadT(vsrc, 8192, tid);
      tile_putT2(VT, tv, tid, wl);
    }
    __syncthreads();
    bf16x8 a[2][4];
    load_fragA(a, VT, wid * 32, fr, fq);
    f32x4 acc[2][8];
#pragma unroll
    for (int mt = 0; mt < 2; ++mt)
#pragma unroll
      for (int nt = 0; nt < 8; ++nt) acc[mt][nt] = f32x4{0.f, 0.f, 0.f, 0.f};
    mma_regA(a, KT, acc, fr, fq);
    store_acc_bf16(p.dC + ((size_t)dir * NITEM + item) * 16384, acc, wid * 32, fr, fq);
    if (tid < 128) {
      const bf16_t* kr = (const bf16_t*)KT + tid * 136;
      float s = 0.f;
#pragma unroll 4
      for (int i = 0; i < 128; ++i) s += wl[i] * bf2f(kr[i]);
      p.dn[((size_t)dir * NITEM + item) * 128 + tid] = s;
    }
    __syncthreads();
  }
}

DEVI void sgu_item(const Params& p, int l, int item, char* smem) {
  int tid_ = TID(); asm volatile("" : "+v"(tid_));
  const int tid = tid_, lane = tid & 63, wid = tid >> 6, fr = lane & 15, fq = lane >> 4;
  const int chunk = item >> 3, g = item & 7, tok0 = chunk * 128;
  char* ZT = smem; char* WS = smem + 34816;
  __syncthreads();
  {
    unsigned* dst = (unsigned*)ZT;
    const float* nw = p.sgu_norm_w + l * 1024 + g * 128;
    const int rp = tid & 63, c0 = (tid >> 6) * 32;
    const bf16_t* ra = p.proj + (size_t)(tok0 + 2 * rp) * 8192 + 5120 + g * 128 + c0;
    const float muA = p.sgu_stats[(tok0 + 2 * rp) * 2], rsA = p.sgu_stats[(tok0 + 2 * rp) * 2 + 1];
    const float muB = p.sgu_stats[(tok0 + 2 * rp + 1) * 2], rsB = p.sgu_stats[(tok0 + 2 * rp + 1) * 2 + 1];
#pragma unroll 2
    for (int i = 0; i < 4; ++i) {
      const uint4 ua = *(const uint4*)(ra + i * 8), ub = *(const uint4*)(ra + 8192 + i * 8);
      const unsigned wa[4] = {ua.x, ua.y, ua.z, ua.w}, wb[4] = {ub.x, ub.y, ub.z, ub.w};
#pragma unroll
      for (int k = 0; k < 4; ++k) {
        const int col = c0 + i * 8 + 2 * k;
        const float n0 = nw[col], n1 = nw[col + 1];
        const unsigned lo = pack2((gelu_f(lo2f(wa[k])) - muA) * rsA * n0, (gelu_f(lo2f(wb[k])) - muB) * rsB * n0);
        const unsigned hi = pack2((gelu_f(hi2f(wa[k])) - muA) * rsA * n1, (gelu_f(hi2f(wb[k])) - muB) * rsB * n1);
        dst[col * 68 + rp] = lo;
        dst[(col + 1) * 68 + rp] = hi;
      }
    }
    const float* ws = p.sgu_w + ((size_t)l * 8 + g) * 16384;
#pragma unroll 4
    for (int i = 0; i < 16; ++i) {
      int c = tid + i * 256, row = c >> 5, c4 = (c & 31) * 4;
      float4 v = *(const float4*)(ws + row * 128 + c4);
      uint2 o; o.x = pack2(v.x, v.y); o.y = pack2(v.z, v.w);
      *(uint2*)(WS + row * 272 + c4 * 2) = o;
    }
  }
  __syncthreads();
  bf16x8 a[2][4];
  load_fragA(a, WS, wid * 32, fr, fq);
  f32x4 acc[2][8];
#pragma unroll
  for (int mt = 0; mt < 2; ++mt)
#pragma unroll
    for (int nt = 0; nt < 8; ++nt) acc[mt][nt] = f32x4{0.f, 0.f, 0.f, 0.f};
  mma_regA(a, ZT, acc, fr, fq);
  const float* bs = p.sgu_b + ((size_t)l * 8 + g) * 128;
#pragma unroll
  for (int mt = 0; mt < 2; ++mt) {
    const int pp = wid * 32 + mt * 16 + fr;
    const float bsv = bs[pp];
#pragma unroll
    for (int nt = 0; nt < 8; ++nt) {
      const int cc = g * 128 + nt * 16 + fq * 4;
      f32x4 u = unpack4(*(const uint2*)(p.proj + (size_t)(tok0 + pp) * 8192 + 4096 + cc));
      f32x4 o = f32x4{gelu_f(u[0]), gelu_f(u[1]), gelu_f(u[2]), gelu_f(u[3])} * (acc[mt][nt] + bsv);
      *(uint2*)(p.hB + (size_t)(tok0 + pp) * 1024 + cc) = pack4(o);
    }
  }
}

DEVI void phase_mloc(const Params& p, int l, char* smem) {
  for (int item = BID(); item < 2 * NITEM; item += gridDim.x) {
    if (item < NITEM) mloc_item(p, item, smem);
    else sgu_item(p, l, item - NITEM, smem);
  }
}

DEVI void phase_scan(const Params& p) {
  const size_t gtid = (size_t)BID() * 256 + TID(), gstride = (size_t)gridDim.x * 256;
  for (size_t i = gtid; i < 32 * 2048; i += gstride) {
    int chain = (int)(i >> 11), e = (int)(i & 2047);
    int dir = chain >> 4, bh = chain & 15;
    float C[8];
#pragma unroll
    for (int j = 0; j < 8; ++j) C[j] = 0.f;
    float nacc[8];
#pragma unroll
    for (int j = 0; j < 8; ++j) nacc[j] = 0.f;
    float m = -1e30f;
#pragma unroll 11
    for (int j = 0; j < 66; ++j) {
      int cidx = dir == 0 ? (j < 2 ? 64 + j : j - 2) : (j < 2 ? 65 - j : 65 - j);
      size_t it = (size_t)dir * NITEM + bh * 66 + cidx;
      uint4 o; o.x = pack2(C[0], C[1]); o.y = pack2(C[2], C[3]); o.z = pack2(C[4], C[5]); o.w = pack2(C[6], C[7]);
      *(uint4*)(p.Cin + it * 16384 + e * 8) = o;
      if (e == 0) p.min_[it] = m;
      uint4 u = *(const uint4*)(p.dC + it * 16384 + e * 8);
      float g = p.cscal[it * 2], ml = p.cscal[it * 2 + 1];
      float mn = fmaxf(g + m, ml);
      float a = __expf(g + m - mn), s = __expf(ml - mn);
      C[0] = a * C[0] + s * lo2f(u.x); C[1] = a * C[1] + s * hi2f(u.x);
      C[2] = a * C[2] + s * lo2f(u.y); C[3] = a * C[3] + s * hi2f(u.y);
      C[4] = a * C[4] + s * lo2f(u.z); C[5] = a * C[5] + s * hi2f(u.z);
      C[6] = a * C[6] + s * lo2f(u.w); C[7] = a * C[7] + s * hi2f(u.w);
      if (e < 16) {
        float4 d0 = *(const float4*)(p.dn + it * 128 + e * 8), d1 = *(const float4*)(p.dn + it * 128 + e * 8 + 4);
        *(float4*)(p.nin + it * 128 + e * 8) = float4{nacc[0], nacc[1], nacc[2], nacc[3]};
        *(float4*)(p.nin + it * 128 + e * 8 + 4) = float4{nacc[4], nacc[5], nacc[6], nacc[7]};
        nacc[0] = a * nacc[0] + s * d0.x; nacc[1] = a * nacc[1] + s * d0.y; nacc[2] = a * nacc[2] + s * d0.z; nacc[3] = a * nacc[3] + s * d0.w;
        nacc[4] = a * nacc[4] + s * d1.x; nacc[5] = a * nacc[5] + s * d1.y; nacc[6] = a * nacc[6] + s * d1.z; nacc[7] = a * nacc[7] + s * d1.w;
      }
      m = mn;
    }
  }
}

DEVI bf16x8 scale_frag(bf16x8 a, float s) {
  asm volatile("" : "+v"(a));
  typedef unsigned u32x4_t __attribute__((ext_vector_type(4)));
  u32x4_t w = __builtin_bit_cast(u32x4_t, a), o;
#pragma unroll
  for (int j = 0; j < 4; ++j) o[j] = pack2(lo2f(w[j]) * s, hi2f(w[j]) * s);
  return __builtin_bit_cast(bf16x8, o);
}

DEVI void mout_item(const Params& p, int l, int item, char* smem) {
  int tid_ = TID(); asm volatile("" : "+v"(tid_));
  const int tid = tid_, lane = tid & 63, wid = tid >> 6, fr = lane & 15, fq = lane >> 4;
  const int cidx = item % 66, bh = item / 66, hh = bh & 7, b = bh >> 3;
  const int tok0 = tok_base(b, cidx);
  char* B0 = smem; char* B1 = smem + 34816;
  float* fa = (float*)(smem + 69632);
  float *fcf = fa, *fif = fa + 128, *fcb = fa + 256, *fib = fa + 384, *bfv = fa + 512, *bbv = fa + 640, *ef = fa + 768, *eb = fa + 896,
        *mtf = fa + 1024, *mtb = fa + 1152, *af = fa + 1280, *ab = fa + 1408, *qnf = fa + 1536, *qnb = fa + 1664, *cf = fa + 1792, *cb = fa + 1920;
  float* nf = fa + 2048 - 0;
  float* nb = nf + 128;
  __syncthreads();
  const size_t itf = (size_t)0 * NITEM + item, itb = (size_t)1 * NITEM + item;
  if (tid < 128) {
    const float* g = p.gates + (size_t)(tok0 + tid) * 32;
    fif[tid] = g[hh]; fcf[tid] = logsigmoid_f(g[8 + hh]); fib[tid] = g[16 + hh]; fcb[tid] = logsigmoid_f(g[24 + hh]);
    nf[tid] = p.nin[itf * 128 + tid]; nb[tid] = p.nin[itb * 128 + tid];
  }
  bf16x8 qa[2][4];
  {
    const bf16_t* qsrc = p.q + (size_t)tok0 * 1024 + hh * 128;
#pragma unroll
    for (int mt = 0; mt < 2; ++mt)
#pragma unroll
      for (int ks = 0; ks < 4; ++ks) qa[mt][ks] = *(const bf16x8*)(qsrc + (size_t)(wid * 32 + mt * 16 + fr) * 1024 + ks * 32 + fq * 8);
  }
  {
    Tile8 tk = tile_load(p.k + (size_t)tok0 * 1024 + hh * 128, 1024, tid);
    TileT tv = tile_loadT(p.proj + (size_t)tok0 * 8192 + 2048 + hh * 128, 8192, tid);
    tile_put_R(B0, tk, tid);
    tile_putT2(B1, tv, tid, nullptr);
  }
  const float m_f = p.min_[itf], m_b = p.min_[itb];
  __syncthreads();
  if (tid < 128) {
    float run = 0.f, pm = -3.0e38f, e = 0.f;
#pragma unroll 8
    for (int i = 0; i <= tid; ++i) { run += fcf[i]; e = fif[i] - run; pm = fmaxf(pm, e); }
    float mt = fmaxf(run + m_f, run + pm);
    bfv[tid] = run; ef[tid] = e; mtf[tid] = mt; af[tid] = __expf(run + m_f - mt);
  } else {
    int t = tid - 128;
    float run = 0.f, pm = -3.0e38f, e = 0.f;
#pragma unroll 8
    for (int i = 127; i >= t; --i) { run += fcb[i]; e = fib[i] - run; pm = fmaxf(pm, e); }
    float mt = fmaxf(run + m_b, run + pm);
    bbv[t] = run; eb[t] = e; mtb[t] = mt; ab[t] = __expf(run + m_b - mt);
  }
  float qn_f[2], qn_b[2];
#pragma unroll
  for (int mt = 0; mt < 2; ++mt) {
    float sf = 0.f, sb = 0.f;
#pragma unroll
    for (int ks = 0; ks < 4; ++ks) {
#pragma unroll
      for (int j = 0; j < 8; ++j) {
        float qv = bf2f((bf16_t)qa[mt][ks][j]);
        sf += qv * nf[ks * 32 + fq * 8 + j]; sb += qv * nb[ks * 32 + fq * 8 + j];
      }
      asm volatile("" ::: "memory");
    }
    sf += __shfl_xor(sf, 16); sf += __shfl_xor(sf, 32);
    sb += __shfl_xor(sb, 16); sb += __shfl_xor(sb, 32);
    qn_f[mt] = sf; qn_b[mt] = sb;
  }
  f32x4 sF[2][8];
#pragma unroll
  for (int mt = 0; mt < 2; ++mt)
#pragma unroll
    for (int nt = 0; nt < 8; ++nt) sF[mt][nt] = f32x4{0.f, 0.f, 0.f, 0.f};
  mma_regA(qa, B0, sF, fr, fq);
  __syncthreads();
  float cfv[2], cbv[2];
  {
    const int wid2 = __builtin_amdgcn_readfirstlane(wid) * 2;
    float xf[2], xb[2], rsF[2], rsB[2], dgF[2], dgB[2];
#pragma unroll
    for (int mt = 0; mt < 2; ++mt) {
      const int tau = wid * 32 + mt * 16 + fr;
      xf[mt] = bfv[tau] - mtf[tau]; xb[mt] = bbv[tau] - mtb[tau];
      rsF[mt] = 0.f; rsB[mt] = 0.f; dgF[mt] = 0.f; dgB[mt] = 0.f;
    }
#pragma unroll
    for (int nt = 0; nt < 8; ++nt) {
      const f32x4 e_f = *(const f32x4*)(ef + nt * 16 + fq * 4), e_b = *(const f32x4*)(eb + nt * 16 + fq * 4);
#pragma unroll
      for (int mt = 0; mt < 2; ++mt) {
        const int rel = nt - (wid2 + mt);
        if (rel < 0) {
#pragma unroll
          for (int r = 0; r < 4; ++r) { float v = sF[mt][nt][r] * __expf(xf[mt] + e_f[r]); rsF[mt] += v; sF[mt][nt][r] = v; }
        } else if (rel > 0) {
#pragma unroll
          for (int r = 0; r < 4; ++r) { float v = sF[mt][nt][r] * __expf(xb[mt] + e_b[r]); rsB[mt] += v; sF[mt][nt][r] = v; }
        } else {
#pragma unroll
          for (int r = 0; r < 4; ++r) {
            const int sg = fq * 4 + r;
            float s0 = sF[mt][nt][r];
            float vf = s0 * __expf(xf[mt] + e_f[r]), vb = s0 * __expf(xb[mt] + e_b[r]);
            if (sg < fr) { rsF[mt] += vf; sF[mt][nt][r] = vf; }
            else if (sg > fr) { rsB[mt] += vb; sF[mt][nt][r] = vb; }
            else { dgF[mt] = vf; dgB[mt] = vb; sF[mt][nt][r] = 0.f; }
          }
        }
      }
    }
    bf16_t* P = (bf16_t*)B0;
#pragma unroll
    for (int mt = 0; mt < 2; ++mt) {
      const int tau = wid * 32 + mt * 16 + fr;
      float a_ = rsF[mt] + dgF[mt], b_ = rsB[mt] + dgB[mt];
      a_ += __shfl_xor(a_, 16); a_ += __shfl_xor(a_, 32);
      b_ += __shfl_xor(b_, 16); b_ += __shfl_xor(b_, 32);
      const float denf = af[tau] * qn_f[mt] + a_, denb = ab[tau] * qn_b[mt] + b_;
      const float rf = frcp(fmaxf(fabsf(denf), __expf(-mtf[tau])));
      const float rb = frcp(fmaxf(fabsf(denb), __expf(-mtb[tau])));
      cfv[mt] = rf * af[tau]; cbv[mt] = rb * ab[tau];
      const float dg = rf * dgF[mt] + rb * dgB[mt];
#pragma unroll
      for (int nt = 0; nt < 8; ++nt) {
        const int rel = nt - (wid2 + mt);
        f32x4 pv;
#pragma unroll
        for (int r = 0; r < 4; ++r) {
          const int sg = fq * 4 + r;
          const float v = sF[mt][nt][r];
          pv[r] = rel < 0 ? rf * v : (rel > 0 ? rb * v : (sg < fr ? rf * v : (sg > fr ? rb * v : dg)));
        }
        *(uint2*)(P + tau * 136 + nt * 16 + fq * 4) = pack4(pv);
      }
      asm volatile("" ::: "memory");
    }
  }
  __syncthreads();
  f32x4 O[2][8];
#pragma unroll
  for (int mt = 0; mt < 2; ++mt)
#pragma unroll
    for (int nt = 0; nt < 8; ++nt) O[mt][nt] = f32x4{0.f, 0.f, 0.f, 0.f};
  {
    bf16x8 pa[2][4];
    load_fragA(pa, B0, wid * 32, fr, fq);
    mma_regA(pa, B1, O, fr, fq);
  }
  __syncthreads();
  {
    Tile8 tcf = tile_load(p.Cin + itf * 16384, 128, tid);
    Tile8 tcb = tile_load(p.Cin + itb * 16384, 128, tid);
    tile_put_R(B0, tcf, tid);
    tile_put_R(B1, tcb, tid);
  }
  __syncthreads();
  {
    bf16x8 qs[2][4];
#pragma unroll
    for (int ks = 0; ks < 4; ++ks) { qs[0][ks] = scale_frag(qa[0][ks], cfv[0]); qs[1][ks] = scale_frag(qa[1][ks], cfv[1]); }
    mma_regA(qs, B0, O, fr, fq);
#pragma unroll
    for (int ks = 0; ks < 4; ++ks) { qs[0][ks] = scale_frag(qa[0][ks], cbv[0]); qs[1][ks] = scale_frag(qa[1][ks], cbv[1]); }
    mma_regA(qs, B1, O, fr, fq);
  }
  const float* nw = p.mlstm_norm_w + l * 1024 + hh * 128;
#pragma unroll
  for (int mt = 0; mt < 2; ++mt) {
    const int tau = wid * 32 + mt * 16 + fr;
    float s = 0.f;
#pragma unroll
    for (int nt = 0; nt < 8; ++nt) s += O[mt][nt][0] + O[mt][nt][1] + O[mt][nt][2] + O[mt][nt][3];
    s += __shfl_xor(s, 16); s += __shfl_xor(s, 32);
    const float mu = s * (1.f / 128.f);
    float v = 0.f;
#pragma unroll
    for (int nt = 0; nt < 8; ++nt)
#pragma unroll
      for (int r = 0; r < 4; ++r) { float d = O[mt][nt][r] - mu; v += d * d; }
    v += __shfl_xor(v, 16); v += __shfl_xor(v, 32);
    const float rs = rsqrtf(v * (1.f / 128.f) + LN_EPS);
    const size_t tok = (size_t)(tok0 + tau);
#pragma unroll
    for (int nt = 0; nt < 8; ++nt) {
      const int vv = nt * 16 + fq * 4;
      const f32x4 og = sigmoid4(unpack4(*(const uint2*)(p.proj + tok * 8192 + 3072 + hh * 128 + vv)));
      const f32x4 nw4 = *(const f32x4*)(nw + vv);
      *(uint2*)(p.hA + tok * 1024 + hh * 128 + vv) = pack4(og * (O[mt][nt] - mu) * rs * nw4);
    }
    asm volatile("" ::: "memory");
  }
}

DEVI void phase_mout(const Params& p, int l, char* smem) {
  const int nG = (NT / 96) * 8;
  const float* bb = p.branch_b + l * 2048 + 1024;
  const int nb = gridDim.x, bid = BID();
  for (int item = bid; item < NITEM; item += nb) mout_item(p, l, item, smem);
  const int n_extra = NITEM % nb, n_light = nb - n_extra;
  if (bid >= n_extra) {
    for (int it = bid - n_extra; it < nG; it += n_light) {
      int mt = it % (NT / 96), nt = it / (NT / 96);
      const bf16_t* proj = p.proj; float* r = p.r;
      gemm96(p.hB, p.wt_pb, mt * 96, nt * 128, smem, [&](int m, int n, const f32x4& v) {
        f32x4 g = unpack4(*(const uint2*)(proj + (size_t)m * 8192 + 7168 + n)) + *(const f32x4*)(bb + n);
        *(f32x4*)(r + (size_t)m * 1024 + n) = sigmoid4(g) * v;
      });
    }
  }
}

DEVI void phase_g2a(const Params& p, int l, char* smem) {
  const int nM = NT / 96;
  const float* ba = p.branch_b + l * 2048;
  const bf16_t* proj = p.proj; const float* r = p.r; bf16_t* merged = p.merged;
  for (int it = 0;; ++it) {
    int mt, nt;
    if (!xcd_tile(it, nM, 8, mt, nt)) break;
    gemm96(p.hA, p.wt_pa, mt * 96, nt * 128, smem, [&](int m, int n, const f32x4& v) {
      f32x4 g = unpack4(*(const uint2*)(proj + (size_t)m * 8192 + 6144 + n)) + *(const f32x4*)(ba + n);
      *(uint2*)(merged + (size_t)m * 1024 + n) = pack4(sigmoid4(g) * v + *(const f32x4*)(r + (size_t)m * 1024 + n));
    });
  }
}

DEVI void phase_g3(const Params& p, int l, char* smem) {
  const int nM = NT / 96;
  const float* z = p.z; float* r = p.r; const float* mod = p.mod + (size_t)l * 3 * 6144;
  for (int it = 0;; ++it) {
    int mt, nt;
    if (!xcd_tile(it, nM, 8, mt, nt)) break;
    gemm96(p.merged, p.wt_out, mt * 96, nt * 128, smem, [&](int m, int n, const f32x4& v) {
      *(f32x4*)(r + (size_t)m * 1024 + n) = DN_ALPHA * *(const f32x4*)(z + (size_t)m * 1024 + n) + *(const f32x4*)(mod + mod_index(m) * 6144 + 2048 + n) * v;
    });
  }
}

DEVI void wave_ln(float (&v)[16], const float* w, const float* bsh, int lane) {
  float s = 0.f;
#pragma unroll
  for (int j = 0; j < 16; ++j) s += v[j];
  float mu = wave_sum(s) * (1.f / 1024.f);
  float q = 0.f;
#pragma unroll
  for (int j = 0; j < 16; ++j) { float d = v[j] - mu; q += d * d; }
  float rs = rsqrtf(wave_sum(q) * (1.f / 1024.f) + LN_EPS);
#pragma unroll
  for (int j = 0; j < 16; ++j) {
    int d = (j < 8 ? 0 : 512) + lane * 8 + (j & 7);
    v[j] = (v[j] - mu) * rs * w[d] + bsh[d];
  }
}
DEVI void load16(const float* src, int lane, float (&v)[16]) {
  float4 a = *(const float4*)(src + lane * 8), b = *(const float4*)(src + lane * 8 + 4);
  float4 c = *(const float4*)(src + 512 + lane * 8), d = *(const float4*)(src + 512 + lane * 8 + 4);
  v[0] = a.x; v[1] = a.y; v[2] = a.z; v[3] = a.w; v[4] = b.x; v[5] = b.y; v[6] = b.z; v[7] = b.w;
  v[8] = c.x; v[9] = c.y; v[10] = c.z; v[11] = c.w; v[12] = d.x; v[13] = d.y; v[14] = d.z; v[15] = d.w;
}
DEVI void store16(float* dst, int lane, const float (&v)[16]) {
  *(float4*)(dst + lane * 8) = float4{v[0], v[1], v[2], v[3]};
  *(float4*)(dst + lane * 8 + 4) = float4{v[4], v[5], v[6], v[7]};
  *(float4*)(dst + 512 + lane * 8) = float4{v[8], v[9], v[10], v[11]};
  *(float4*)(dst + 512 + lane * 8 + 4) = float4{v[12], v[13], v[14], v[15]};
}
DEVI void store16_mod_bf16(bf16_t* dst, int lane, const float (&v)[16], const float* shift, const float* scale) {
  float h[16];
#pragma unroll
  for (int j = 0; j < 16; ++j) {
    int d = (j < 8 ? 0 : 512) + lane * 8 + (j & 7);
    h[j] = v[j] * (1.f + scale[d]) + shift[d];
  }
  uint4 o0, o1;
  o0.x = pack2(h[0], h[1]); o0.y = pack2(h[2], h[3]); o0.z = pack2(h[4], h[5]); o0.w = pack2(h[6], h[7]);
  o1.x = pack2(h[8], h[9]); o1.y = pack2(h[10], h[11]); o1.z = pack2(h[12], h[13]); o1.w = pack2(h[14], h[15]);
  *(uint4*)(dst + lane * 8) = o0;
  *(uint4*)(dst + 512 + lane * 8) = o1;
}

DEVI void phase_ln1(const Params& p, int l) {
  const int lane = TID() & 63;
  const int gw = (BID() * 256 + TID()) >> 6, nw = gridDim.x * 4;
  for (int tok = gw; tok < NT; tok += nw) {
    float v[16];
    load16(p.r + (size_t)tok * 1024, lane, v);
    wave_ln(v, p.ln_w + (size_t)(l * 2 + 0) * 1024, p.ln_b + (size_t)(l * 2 + 0) * 1024, lane);
    store16(p.z + (size_t)tok * 1024, lane, v);
    const float* m = p.mod + ((size_t)l * 3 + mod_index(tok)) * 6144;
    store16_mod_bf16(p.h + (size_t)tok * 1024, lane, v, m + 3 * 1024, m + 4 * 1024);
  }
}

DEVI void phase_g4(const Params& p, int l, char* smem) {
  bf16_t* qry = p.qry;
  auto epi = [&](int m, int n, const f32x4& v) { *(uint2*)(qry + (size_t)m * 2048 + n) = pack4(v); };
  for (int it = 0;; ++it) {
    int mt, nt;
    if (!xcd_tile(it, 64, 16, mt, nt)) break;
    gemm256g(p.h, p.wt_q, mt * 256, nt * 128, smem, epi, qry, 2048, 2048);
  }
  for (int it = 0;; ++it) {
    int mt, nt;
    if (!xcd_tile(it, (NT - 16384) / 128, 16, mt, nt)) break;
    gemm128g(p.h, p.wt_q, 16384 + mt * 128, nt * 128, smem, epi);
  }
}

DEVI unsigned ord_enc(float f) { unsigned u = __float_as_uint(f); return (u & 0x80000000u) ? ~u : (u | 0x80000000u); }
DEVI float ord_dec(unsigned k) { unsigned u = (k & 0x80000000u) ? (k ^ 0x80000000u) : ~k; return __uint_as_float(u); }
DEVI unsigned umed3(unsigned a, unsigned b, unsigned c) { unsigned d; asm("v_med3_u32 %0, %1, %2, %3" : "=v"(d) : "v"(a), "v"(b), "v"(c)); return d; }
DEVI void ins16(unsigned (&r)[16], unsigned x) {
#pragma unroll
  for (int i = 15; i >= 1; --i) r[i] = umed3(r[i - 1], r[i], x);
  r[0] = max(r[0], x);
}

DEVI void merge16(unsigned (&r)[16], const unsigned (&o)[16]) {
#pragma unroll
  for (int i = 0; i < 16; ++i) r[i] = max(r[i], o[15 - i]);
#pragma unroll
  for (int st = 8; st >= 1; st >>= 1)
#pragma unroll
    for (int i = 0; i < 16; ++i)
      if ((i & st) == 0) { unsigned hi = max(r[i], r[i + st]), lo = min(r[i], r[i + st]); r[i] = hi; r[i + st] = lo; }
}
DEVI void phase_topk(const Params& p, int l, char* smem) {
  const int tid = TID(), lane = tid & 63, wid = tid >> 6, fr = lane & 15, fq = lane >> 4;
  const int hh = BID() & 7;
  __syncthreads();
  {
    const bf16_t* ksrc = p.keys + (size_t)(l & 1) * 262144 + (size_t)hh * 2 * 16384;
    Tile8 k0 = tile_load(ksrc, 128, tid);
    Tile8 k1 = tile_load(ksrc + 16384, 128, tid);
    tile_put_R(smem, k0, tid);
    tile_put_R(smem + 34816, k1, tid);
  }
  __syncthreads();
  unsigned* tab = (unsigned*)(smem + 69632) + (size_t)(wid * 16 + fr) * 32;
  const int ntg = NT / 16, tg_stride = (int)(gridDim.x >> 3) * 4;
  for (int tg = (BID() >> 3) * 4 + wid; tg < ntg; tg += tg_stride) {
    const int t0 = tg * 16;
    unsigned top[2][16];
#pragma unroll
    for (int ph = 0; ph < 2; ++ph) {
      const char* kb = smem + ph * 34816;
      const bf16_t* qb = p.qry + (size_t)(t0 + fr) * 2048 + hh * 256 + ph * 128;
      f32x4 acc[8];
#pragma unroll
      for (int mt = 0; mt < 8; ++mt) acc[mt] = f32x4{0.f, 0.f, 0.f, 0.f};
#pragma unroll
      for (int ks = 0; ks < 4; ++ks) {
        bf16x8 bq = *(const bf16x8*)(qb + ks * 32 + fq * 8);
#pragma unroll
        for (int mt = 0; mt < 8; ++mt) {
          bf16x8 ak = *(const bf16x8*)(kb + (mt * 16 + fr) * 272 + ks * 64 + fq * 16);
          acc[mt] = __builtin_amdgcn_mfma_f32_16x16x32_bf16(ak, bq, acc[mt], 0, 0, 0);
        }
      }
#pragma unroll
      for (int i = 0; i < 16; ++i) top[ph][i] = 0u;
#pragma unroll
      for (int mt = 0; mt < 8; ++mt)
#pragma unroll
        for (int r = 0; r < 4; ++r) {
          unsigned key = (ord_enc(acc[mt][r]) & ~0x7Fu) | (unsigned)(127 - (mt * 16 + fq * 4 + r));
          ins16(top[ph], key);
        }
#pragma unroll
      for (int st = 16; st <= 32; st <<= 1) {
        unsigned o[16];
#pragma unroll
        for (int i = 0; i < 16; ++i) o[i] = (unsigned)__shfl_xor((int)top[ph][i], st);
        merge16(top[ph], o);
      }
    }
    unsigned cd[16];
#pragma unroll
    for (int i = 0; i < 16; ++i) cd[i] = 0u;
    float v0[16], v1[16];
#pragma unroll
    for (int i = 0; i < 16; ++i) {
      v0[i] = ord_dec(top[0][i] & ~0x7Fu); v1[i] = ord_dec(top[1][i] & ~0x7Fu);
      tab[i] = 127u - (top[0][i] & 0x7Fu); tab[16 + i] = 127u - (top[1][i] & 0x7Fu);
    }
#pragma unroll
    for (int a = 0; a < 16; ++a)
#pragma unroll
      for (int bq = 0; bq < 16; ++bq)
        if ((a + 1) * (bq + 1) <= 16) {
          unsigned key = (ord_enc(v0[a] + v1[bq]) & ~0xFFu) | (unsigned)(255 - (a * 16 + bq));
          ins16(cd, key);
        }
    float sv[16];
    int ei[16];
    float mx = ord_dec(cd[0] & ~0xFFu), sum = 0.f;
#pragma unroll
    for (int i = 0; i < 16; ++i) {
      unsigned code = 255u - (cd[i] & 0xFFu);
      sv[i] = __expf(ord_dec(cd[i] & ~0xFFu) - mx);
      sum += sv[i];
      ei[i] = (int)(tab[code >> 4] * 128u + tab[16 + (code & 15u)]);
    }
    float inv = 1.f / sum;
    if (fq == 0) {
      int* di = p.eidx + (size_t)(t0 + fr) * 128 + hh * 16;
      float* dg = p.egate + (size_t)(t0 + fr) * 128 + hh * 16;
#pragma unroll
      for (int i = 0; i < 16; i += 4) {
        *(int4*)(di + i) = int4{ei[i], ei[i + 1], ei[i + 2], ei[i + 3]};
        *(float4*)(dg + i) = float4{sv[i] * inv, sv[i + 1] * inv, sv[i + 2] * inv, sv[i + 3] * inv};
      }
    }
  }
}

typedef float v2f_t __attribute__((ext_vector_type(2)));
DEVI float dot16_fp8(const uint4& a, const float (&x)[16]) {
  const unsigned w[4] = {a.x, a.y, a.z, a.w};
  float s0 = 0.f, s1 = 0.f;
#pragma unroll
  for (int i = 0; i < 4; ++i) {
    v2f_t lo = __builtin_amdgcn_cvt_pk_f32_fp8((int)w[i], false), hi = __builtin_amdgcn_cvt_pk_f32_fp8((int)w[i], true);
    s0 += lo[0] * x[4 * i]; s1 += lo[1] * x[4 * i + 1]; s0 += hi[0] * x[4 * i + 2]; s1 += hi[1] * x[4 * i + 3];
  }
  return s0 + s1;
}
DEVI void axpy16_fp8(float (&o)[16], float c, const uint4& a) {
  const unsigned w[4] = {a.x, a.y, a.z, a.w};
#pragma unroll
  for (int i = 0; i < 4; ++i) {
    v2f_t lo = __builtin_amdgcn_cvt_pk_f32_fp8((int)w[i], false), hi = __builtin_amdgcn_cvt_pk_f32_fp8((int)w[i], true);
    o[4 * i] += c * lo[0]; o[4 * i + 1] += c * lo[1]; o[4 * i + 2] += c * hi[0]; o[4 * i + 3] += c * hi[1];
  }
}
DEVI void load16c(const float* src, int lane, float (&v)[16]) {
#pragma unroll
  for (int i = 0; i < 4; ++i) {
    float4 a = *(const float4*)(src + lane * 16 + i * 4);
    v[4 * i] = a.x; v[4 * i + 1] = a.y; v[4 * i + 2] = a.z; v[4 * i + 3] = a.w;
  }
}
DEVI void store16c(float* dst, int lane, const float (&v)[16]) {
#pragma unroll
  for (int i = 0; i < 4; ++i) *(float4*)(dst + lane * 16 + i * 4) = float4{v[4 * i], v[4 * i + 1], v[4 * i + 2], v[4 * i + 3]};
}

DEVI void phase_gather(const Params& p, int l) {
  const int lane = TID() & 63;
  const int gw = (BID() * 256 + TID()) >> 6, nw = gridDim.x * 4;
  for (int tok = gw; tok < NT; tok += nw) {
    float x[16];
    {
      const bf16_t* hs = p.h + (size_t)tok * 1024 + lane * 16;
      uint4 a0 = *(const uint4*)(hs), a1 = *(const uint4*)(hs + 8);
      x[0] = lo2f(a0.x); x[1] = hi2f(a0.x); x[2] = lo2f(a0.y); x[3] = hi2f(a0.y); x[4] = lo2f(a0.z); x[5] = hi2f(a0.z); x[6] = lo2f(a0.w); x[7] = hi2f(a0.w);
      x[8] = lo2f(a1.x); x[9] = hi2f(a1.x); x[10] = lo2f(a1.y); x[11] = hi2f(a1.y); x[12] = lo2f(a1.z); x[13] = hi2f(a1.z); x[14] = lo2f(a1.w); x[15] = hi2f(a1.w);
    }
    float o[16];
#pragma unroll
    for (int j = 0; j < 16; ++j) o[j] = 0.f;
    const int* ei = p.eidx + (size_t)tok * 128;
    const float* eg = p.egate + (size_t)tok * 128;
    const int myi0 = ei[lane], myi1 = ei[64 + lane];
    const float* esc = p.escale + (l & 1) * 32768;
    const unsigned char* eub = p.eu + (size_t)(l & 1) * 16384 * 1024;
    const unsigned char* evb = p.ev + (size_t)(l & 1) * 16384 * 1024;
    const float mys0 = esc[myi0], mys1 = esc[myi1];
    const float myg0 = eg[lane] * esc[16384 + myi0], myg1 = eg[64 + lane] * esc[16384 + myi1];
#ifdef PROBE_GATHER
#pragma unroll 1
    for (int half4 = 0; half4 < 4; ++half4) {
      const int half = half4 & 1;
      const int myi = half ? myi1 : myi0; const float mys = half ? mys1 : mys0; const float myg = (half ? myg1 : myg0) * 0.5f;
#else
#pragma unroll 1
    for (int half = 0; half < 2; ++half) {
      const int myi = half ? myi1 : myi0; const float mys = half ? mys1 : mys0; const float myg = half ? myg1 : myg0;
#endif
#pragma unroll 1
      for (int e0 = 0; e0 < 64; e0 += 8) {
        uint4 u[8], v[8]; float gt[8], su[8];
#pragma unroll
        for (int j = 0; j < 8; ++j) {
          const int e = __builtin_amdgcn_readlane(myi, e0 + j);
          gt[j] = __builtin_bit_cast(float, __builtin_amdgcn_readlane(__builtin_bit_cast(int, myg), e0 + j));
          su[j] = __builtin_bit_cast(float, __builtin_amdgcn_readlane(__builtin_bit_cast(int, mys), e0 + j));
          u[j] = *(const uint4*)(eub + (size_t)e * 1024 + lane * 16);
          v[j] = *(const uint4*)(evb + (size_t)e * 1024 + lane * 16);
        }
        float d[8];
#pragma unroll
        for (int j = 0; j < 8; ++j) d[j] = dot16_fp8(u[j], x);
#pragma unroll
        for (int of = 32; of > 0; of >>= 1) {
#pragma unroll
          for (int j = 0; j < 8; ++j) d[j] += __shfl_xor(d[j], of);
        }
#pragma unroll
        for (int j = 0; j < 8; ++j) axpy16_fp8(o, gt[j] * gelu_f(su[j] * d[j]), v[j]);
      }
    }
    const float* m = p.mod + ((size_t)l * 3 + mod_index(tok)) * 6144;
    float zv[16];
    load16c(p.z + (size_t)tok * 1024, lane, zv);
    float s = 0.f;
#pragma unroll
    for (int j = 0; j < 16; ++j) { zv[j] = DN_ALPHA * zv[j] + m[5 * 1024 + lane * 16 + j] * o[j]; s += zv[j]; }
    const float mu = wave_sum(s) * (1.f / 1024.f);
    float q = 0.f;
#pragma unroll
    for (int j = 0; j < 16; ++j) { float dd = zv[j] - mu; q += dd * dd; }
    const float rs = rsqrtf(wave_sum(q) * (1.f / 1024.f) + LN_EPS);
    const float* lw = p.ln_w + (size_t)(l * 2 + 1) * 1024 + lane * 16;
    const float* lb = p.ln_b + (size_t)(l * 2 + 1) * 1024 + lane * 16;
#pragma unroll
    for (int j = 0; j < 16; ++j) zv[j] = (zv[j] - mu) * rs * lw[j] + lb[j];
    if (l == DEPTH - 1) {
      if (tok < NTX) store16c(p.out + (size_t)tok * 1024, lane, zv);
    } else {
      store16c(p.z + (size_t)tok * 1024, lane, zv);
      const float* m2 = p.mod + ((size_t)(l + 1) * 3 + mod_index(tok)) * 6144 + lane * 16;
      float hh[16];
#pragma unroll
      for (int j = 0; j < 16; ++j) hh[j] = zv[j] * (1.f + m2[1024 + j]) + m2[j];
      uint4 o0, o1;
      o0.x = pack2(hh[0], hh[1]); o0.y = pack2(hh[2], hh[3]); o0.z = pack2(hh[4], hh[5]); o0.w = pack2(hh[6], hh[7]);
      o1.x = pack2(hh[8], hh[9]); o1.y = pack2(hh[10], hh[11]); o1.z = pack2(hh[12], hh[13]); o1.w = pack2(hh[14], hh[15]);
      bf16_t* hd = p.h + (size_t)tok * 1024 + lane * 16;
      *(uint4*)hd = o0; *(uint4*)(hd + 8) = o1;
    }
  }
}

DEVI void run_phase(const Params& p, int ph, int l, char* smem) {
  if (ph == PH_PREP || ph == PH_TOPK) {
    const bool do_topk = ph == PH_TOPK;
    const bool do_prep = ph == PH_PREP || l < DEPTH - 1;
    const int lp = ph == PH_PREP ? l : l + 1;
    const bool prep_first = !do_topk || !((BID() >> 8) & 1);
#pragma unroll 1
    for (int step = 0; step < 2; ++step) {
      const bool prep_now = (step == 0) == prep_first;
      if (prep_now) { if (do_prep) phase_prep(p, lp, smem); }
      else { if (do_topk) phase_topk(p, l, smem); }
    }
    return;
  }
  switch (ph) {
    case PH_MOD: phase_mod(p, smem); break;
    case PH_PREP: break;
    case PH_G1: phase_g1(p, l, smem); break;
    case PH_CONV: phase_conv(p, l, smem); break;
    case PH_MLOC: phase_mloc(p, l, smem); break;
    case PH_SCAN: phase_scan(p); break;
    case PH_MOUT: phase_mout(p, l, smem); break;
    case PH_G2A: phase_g2a(p, l, smem); break;
    case PH_G3: phase_g3(p, l, smem); break;
    case PH_LN1: phase_ln1(p, l); break;
    case PH_G4: phase_g4(p, l, smem); break;
    case PH_TOPK: break;
    case PH_GATHER: phase_gather(p, l); break;
    default: break;
  }
}

__global__ void __launch_bounds__(256, 2) k_phase(Params p, int ph, int l) {
  extern __shared__ __attribute__((aligned(16))) char smem[];
  run_phase(p, ph, l, smem);
}

__global__ void __launch_bounds__(256, 2) k_mega(Params p) {
  extern __shared__ __attribute__((aligned(16))) char smem[];
  __shared__ uint4 xb_words;
  cg::grid_group grid = cg::this_grid();
  if (__builtin_amdgcn_workitem_id_x() == 0) xb_words = make_uint4(0u, 0u, 0u, 0u);
  __syncthreads();
  XcdBarrier xb = xcd_barrier_post(p.bar, (volatile LAS unsigned*)&xb_words);
  run_phase(p, PH_MOD, 0, smem);
  grid.sync();
  for (int l = 0; l < DEPTH; ++l) {
    for (int ph = (l == 0 ? PH_PREP : PH_G1); ph < PH_COUNT; ++ph) {
      run_phase(p, ph, l, smem);
#ifdef PROBE_PH
      if ((PROBE_PH >> ph) & 1) { xcd_barrier(xb); run_phase(p, ph, l, smem); }
#endif
      if (!(l == DEPTH - 1 && ph == PH_COUNT - 1)) xcd_barrier(xb);
    }
  }
}

extern "C" void kernel_launch(void* const* d_in, const int* in_sizes, int n_in, void* d_out, int out_size, void* d_ws,
                              size_t ws_size, hipStream_t stream) {
  Params p{};
  const float** pin = (const float**)&p;
  for (int i = 0; i < 24; ++i) pin[i] = (const float*)d_in[i];
  p.out = (float*)d_out;
  char* w = (char*)d_ws;
  size_t off = 0;
  auto take = [&](size_t bytes) { char* r = w + off; off += (bytes + 255) & ~(size_t)255; return r; };
  p.mod = (float*)take((size_t)4 * 3 * 6144 * 4);
  p.wt_in = (bf16_t*)take((size_t)INWP * 1024 * 2);
  p.wt_pa = (bf16_t*)take((size_t)1024 * 1024 * 2);
  p.wt_pb = (bf16_t*)take((size_t)1024 * 1024 * 2);
  p.wt_out = (bf16_t*)take((size_t)1024 * 1024 * 2);
  p.wt_q = (bf16_t*)take((size_t)2048 * 1024 * 2);
  p.keys = (bf16_t*)take((size_t)2 * 262144 * 2);
  p.eu = (unsigned char*)take((size_t)2 * 16384 * 1024);
  p.ev = (unsigned char*)take((size_t)2 * 16384 * 1024);
  p.escale = (float*)take((size_t)2 * 2 * 16384 * 4);
  p.z = (float*)take((size_t)NT * 1024 * 4);
  p.r = (float*)take((size_t)NT * 1024 * 4);
  p.h = (bf16_t*)take((size_t)NT * 1024 * 2);
  p.proj = (bf16_t*)take((size_t)NT * 8192 * 2);
  p.gates = (float*)take((size_t)NT * 32 * 4);
  p.q = (bf16_t*)take((size_t)NT * 1024 * 2);
  p.k = (bf16_t*)take((size_t)NT * 1024 * 2);
  p.sgu_stats = (float*)take((size_t)NT * 2 * 4);
  p.hA = (bf16_t*)take((size_t)NT * 1024 * 2);
  p.hB = (bf16_t*)take((size_t)NT * 1024 * 2);
  p.merged = (bf16_t*)take((size_t)NT * 1024 * 2);
  p.qry = p.proj;
  p.dC = (bf16_t*)take((size_t)2 * NITEM * 16384 * 2);
  p.Cin = (bf16_t*)take((size_t)2 * NITEM * 16384 * 2);
  p.dn = (float*)take((size_t)2 * NITEM * 128 * 4);
  p.nin = (float*)take((size_t)2 * NITEM * 128 * 4);
  p.cscal = (float*)take((size_t)2 * NITEM * 2 * 4);
  p.min_ = (float*)take((size_t)2 * NITEM * 4);
  p.eidx = (int*)take((size_t)NT * 128 * 4);
  p.egate = (float*)take((size_t)NT * 128 * 4);
  p.bar = (unsigned*)take((size_t)XCD_BAR_WORDS * 4);
  if (off > ws_size) { fprintf(stderr, "workspace too small: need %zu have %zu\n", off, ws_size); return; }

#if MEGA
  static int grid_blocks = 0;
  if (!grid_blocks) {
    (void)hipFuncSetAttribute((const void*)k_mega, hipFuncAttributeMaxDynamicSharedMemorySize, LDS_BYTES);
    int dev = 0, cus = 0, per_cu = 0;
    hipGetDevice(&dev);
    hipDeviceGetAttribute(&cus, hipDeviceAttributeMultiprocessorCount, dev);
    hipOccupancyMaxActiveBlocksPerMultiprocessor(&per_cu, k_mega, 256, LDS_BYTES);
    if (per_cu > 2) per_cu = 2;
    grid_blocks = cus * per_cu;
  }
  (void)hipMemsetAsync(p.bar, 0, (size_t)XCD_BAR_WORDS * 4, stream);
  void* args[] = {&p};
  hipError_t e = hipLaunchCooperativeKernel((void*)k_mega, dim3(grid_blocks), dim3(256), args, LDS_BYTES, stream);
  if (e != hipSuccess) fprintf(stderr, "cooperative launch failed: %s (grid %d)\n", hipGetErrorString(e), grid_blocks);
#else
  static bool attr = false;
  if (!attr) { (void)hipFuncSetAttribute((const void*)k_phase, hipFuncAttributeMaxDynamicSharedMemorySize, LDS_BYTES); attr = true; }
  const int grid = 512;
  k_phase<<<grid, 256, LDS_BYTES, stream>>>(p, PH_MOD, 0);
  for (int l = 0; l < DEPTH; ++l)
    for (int ph = PH_PREP; ph < PH_COUNT; ++ph) k_phase<<<grid, 256, LDS_BYTES, stream>>>(p, ph, l);
#endif
}
```

```cpp
#include <hip/hip_runtime.h>
#include <hip/hip_cooperative_groups.h>
#include <cstdio>
namespace cg = cooperative_groups;

#ifndef MEGA
#define MEGA 1
#endif

typedef unsigned short bf16_t;
using bf16x8 = __attribute__((ext_vector_type(8))) short;
using f32x4 = __attribute__((ext_vector_type(4))) float;
#define DEVI __device__ __forceinline__

constexpr int NTX = 16384, NTC = 512, NT = 16896, DEPTH = 4;
constexpr int INW = 8224, INWP = 8320;
constexpr int NITEM = 1056;
constexpr int LDS_BYTES = 79872;
constexpr int NBLK_THREADS = 256;
constexpr float DN_ALPHA = 1.681792830507429f;
constexpr float LN_EPS = 1e-5f;

enum { PH_MOD = 0, PH_PREP, PH_G1, PH_CONV, PH_MLOC, PH_SCAN, PH_MOUT, PH_G2A, PH_G3, PH_LN1, PH_G4, PH_TOPK, PH_GATHER, PH_COUNT };

struct Params {
  const float *x, *c, *ctx, *c_ctx, *w_mod, *b_mod, *w_in, *qk_conv_w, *qk_conv_b, *gate_b, *mlstm_norm_w,
      *sgu_norm_w, *sgu_w, *sgu_b, *branch_b, *p_a, *p_b, *w_out, *ln_w, *ln_b, *peer_wq, *peer_keys, *expert_u, *expert_v;
  float* out;
  float* mod;
  bf16_t* wt_in;
  bf16_t* wt_pa;
  bf16_t* wt_pb;
  bf16_t* wt_out;
  bf16_t* wt_q;
  bf16_t* keys;
  unsigned char* eu;
  unsigned char* ev;
  float* escale;
  float* z;
  float* r;
  bf16_t* h;
  bf16_t* proj;
  float* gates;
  bf16_t* q;
  bf16_t* k;
  float* sgu_stats;
  bf16_t* hA;
  bf16_t* hB;
  bf16_t* merged;
  bf16_t* qry;
  bf16_t* dC;
  bf16_t* Cin;
  float* dn;
  float* nin;
  float* cscal;
  float* min_;
  int* eidx;
  float* egate;
  unsigned* bar;
};

DEVI int TID() { int t = __builtin_amdgcn_workitem_id_x(); asm volatile("" : "+v"(t)); return t; }
DEVI int BID() { int b = __builtin_amdgcn_workgroup_id_x(); asm volatile("" : "+s"(b)); return b; }
DEVI float bf2f(bf16_t h) { return __uint_as_float(((unsigned)h) << 16); }
typedef __bf16 hwbf2_t __attribute__((ext_vector_type(2)));
typedef float hwf2_t __attribute__((ext_vector_type(2)));
DEVI unsigned pack2(float a, float b) { hwf2_t v = {a, b}; hwbf2_t r = __builtin_convertvector(v, hwbf2_t); return __builtin_bit_cast(unsigned, r); }
DEVI bf16_t f2bf(float f) { return (bf16_t)(pack2(f, f) & 0xFFFFu); }
DEVI float lo2f(unsigned u) { return __uint_as_float(u << 16); }
DEVI float hi2f(unsigned u) { return __uint_as_float(u & 0xFFFF0000u); }
DEVI float frcp(float x) { return __builtin_amdgcn_rcpf(x); }
DEVI float sigmoid_f(float x) { return frcp(1.f + __expf(-x)); }
DEVI float silu_f(float x) { return x * frcp(1.f + __expf(-x)); }
DEVI float gelu_f(float x) { float u = 0.7978845608028654f * (x + 0.044715f * x * x * x); return x * frcp(1.f + __expf(-2.f * u)); }
DEVI float logsigmoid_f(float x) { return fminf(x, 0.f) - log1pf(__expf(-fabsf(x))); }
DEVI uint2 pack4(const f32x4& v) { uint2 o; o.x = pack2(v[0], v[1]); o.y = pack2(v[2], v[3]); return o; }
DEVI f32x4 unpack4(uint2 u) { return f32x4{lo2f(u.x), hi2f(u.x), lo2f(u.y), hi2f(u.y)}; }
DEVI f32x4 sigmoid4(const f32x4& x) { return f32x4{sigmoid_f(x[0]), sigmoid_f(x[1]), sigmoid_f(x[2]), sigmoid_f(x[3])}; }
DEVI int mod_index(int tok) { return tok < 8192 ? 0 : (tok < 16384 ? 1 : 2); }
DEVI int tok_base(int b, int cidx) { return cidx < 64 ? b * 8192 + cidx * 128 : NTX + b * 256 + (cidx - 64) * 128; }
DEVI float wave_sum(float v) {
#pragma unroll
  for (int o = 32; o > 0; o >>= 1) v += __shfl_xor(v, o);
  return v;
}


#define XB_TMO      128
#define XB_XCNT(j)  (256  + 64 * (j))
#define XB_XSUB(j)  (1280 + 64 * (j))
#define XB_XGEN(j)  (2304 + 64 * (j))
#define XB_TOP      3328
#define XB_TOPGEN   3392
#define XCD_BAR_WORDS 3456
#define XB_SPIN_CAP (1u << 20)
#define LAS __attribute__((address_space(3)))
DEVI unsigned xb_ld(unsigned* p) { return __hip_atomic_load(p, __ATOMIC_RELAXED, __HIP_MEMORY_SCOPE_AGENT); }
DEVI unsigned xb_add(unsigned* p, unsigned v) { return __hip_atomic_fetch_add(p, v, __ATOMIC_RELAXED, __HIP_MEMORY_SCOPE_AGENT); }
DEVI unsigned xb_xcc_id() { return (unsigned)__builtin_amdgcn_s_getreg((3 << 11) | 20) & 0xFu; }
#define XB_SPIN(cond, bar) do { unsigned _sp = 0; while (cond) { __builtin_amdgcn_s_sleep(1); \
    if ((++_sp & 255u) == 0u) { if (xb_ld(&(bar)[XB_TMO])) break; if (_sp > XB_SPIN_CAP) { atomicAdd(&(bar)[XB_TMO], 1u); break; } } } } while (0)
struct XcdBarrier { unsigned* bar; unsigned x; volatile LAS unsigned* st; };
DEVI XcdBarrier xcd_barrier_post(unsigned* bar, volatile LAS unsigned* st) {
  XcdBarrier b; b.bar = bar; b.x = xb_xcc_id(); b.st = st;
  if (__builtin_amdgcn_workitem_id_x() == 0) (void)xb_add(&bar[XB_XCNT(b.x)], 1u);
  return b;
}
DEVI void xcd_barrier_complete(unsigned* bar, unsigned x, unsigned& nloc, unsigned& nx) {
  const unsigned G = gridDim.x * gridDim.y * gridDim.z;
  unsigned sum, cnt, mine, sp = 0u;
  for (;;) {
    sum = 0u; cnt = 0u; mine = 0u;
#pragma unroll
    for (unsigned j = 0; j < 16; ++j) { const unsigned c = xb_ld(&bar[XB_XCNT(j)]); sum += c; cnt += (c > 0u) ? 1u : 0u; mine = (j == x) ? c : mine; }
    if (sum == G) break;
    __builtin_amdgcn_s_sleep(1);
    if ((++sp & 255u) == 0u) { if (xb_ld(&bar[XB_TMO])) break; if (sp > XB_SPIN_CAP) { atomicAdd(&bar[XB_TMO], 1u); break; } }
  }
  nloc = mine > 0u ? mine : 1u; nx = cnt > 0u ? cnt : 1u;
}
DEVI void xcd_barrier(const XcdBarrier& b) {
  asm volatile("s_waitcnt vmcnt(0)" ::: "memory");
  __syncthreads();
  if (__builtin_amdgcn_workitem_id_x() == 0) {
    unsigned* bar = b.bar;
    __builtin_amdgcn_s_waitcnt(0);
    unsigned nloc = b.st[0], nx = b.st[1];
    if (nloc == 0u) { xcd_barrier_complete(bar, b.x, nloc, nx); b.st[0] = nloc; b.st[1] = nx; }
    const unsigned old = xb_add(&bar[XB_XSUB(b.x)], 1u);
    const unsigned gen = old / nloc;
    if (old + 1u == (gen + 1u) * nloc) {
      __builtin_amdgcn_fence(__ATOMIC_RELEASE, "agent");
      asm volatile("s_waitcnt vmcnt(0)" ::: "memory");
      const unsigned og = xb_add(&bar[XB_TOP], 1u);
      const unsigned tg = og / nx;
      if (og + 1u == (tg + 1u) * nx) xb_add(&bar[XB_TOPGEN], 1u);
      else XB_SPIN(xb_ld(&bar[XB_TOPGEN]) == tg, bar);
      __builtin_amdgcn_fence(__ATOMIC_ACQUIRE, "agent");
      xb_add(&bar[XB_XGEN(b.x)], 1u);
      asm volatile("s_waitcnt vmcnt(0)" ::: "memory");
    } else {
      XB_SPIN(xb_ld(&bar[XB_XGEN(b.x)]) == gen, bar);
      __builtin_amdgcn_fence(__ATOMIC_ACQUIRE, "agent");
      asm volatile("s_waitcnt vmcnt(0)" ::: "memory");
    }
  }
  __syncthreads();
}

template <int MI, class Epi>
DEVI void gemm_t(const bf16_t* __restrict__ A, const bf16_t* __restrict__ Bt, int m0, int n0, char* smem, Epi epi) {
  const int tid = TID(), lane = tid & 63, wid = tid >> 6, wr = wid >> 1, wc = wid & 1, fr = lane & 15, fq = lane >> 4;
  f32x4 acc[MI][4];
#pragma unroll
  for (int i = 0; i < MI; ++i)
#pragma unroll
    for (int j = 0; j < 4; ++j) acc[i][j] = f32x4{0.f, 0.f, 0.f, 0.f};
  const int srow = tid >> 3, scol = (tid & 7) * 8;
  const bf16_t* ga = A + (size_t)(m0 + srow) * 1024 + scol;
  const bf16_t* gb = Bt + (size_t)(n0 + srow) * 1024 + scol;
  uint4 pa0, pa1, pa2, pa3 = uint4{0, 0, 0, 0}, pb0, pb1, pb2, pb3, qa0, qa1, qa2, qa3 = uint4{0, 0, 0, 0}, qb0, qb1, qb2, qb3;
#define G_LOAD(P, KO) \
  P##a0 = *(const uint4*)(ga + (size_t)0 * 32 * 1024 + (KO)); P##a1 = *(const uint4*)(ga + (size_t)1 * 32 * 1024 + (KO)); \
  P##a2 = *(const uint4*)(ga + (size_t)2 * 32 * 1024 + (KO)); if (MI == 4) P##a3 = *(const uint4*)(ga + (size_t)3 * 32 * 1024 + (KO)); \
  P##b0 = *(const uint4*)(gb + (size_t)0 * 32 * 1024 + (KO)); P##b1 = *(const uint4*)(gb + (size_t)1 * 32 * 1024 + (KO)); \
  P##b2 = *(const uint4*)(gb + (size_t)2 * 32 * 1024 + (KO)); P##b3 = *(const uint4*)(gb + (size_t)3 * 32 * 1024 + (KO));
#define G_STORE(P, BASE) \
  *(uint4*)((BASE) + swoff + 0 * 32 * 144) = P##a0; *(uint4*)((BASE) + swoff + 1 * 32 * 144) = P##a1; \
  *(uint4*)((BASE) + swoff + 2 * 32 * 144) = P##a2; if (MI == 4) *(uint4*)((BASE) + swoff + 3 * 32 * 144) = P##a3; \
  *(uint4*)((BASE) + 18432 + swoff + 0 * 32 * 144) = P##b0; *(uint4*)((BASE) + 18432 + swoff + 1 * 32 * 144) = P##b1; \
  *(uint4*)((BASE) + 18432 + swoff + 2 * 32 * 144) = P##b2; *(uint4*)((BASE) + 18432 + swoff + 3 * 32 * 144) = P##b3;
#define G_COMPUTE(BASE) \
  _Pragma("unroll") for (int ks = 0; ks < 2; ++ks) { \
    bf16x8 a[MI], b[4]; \
    _Pragma("unroll") for (int i = 0; i < MI; ++i) a[i] = *(const bf16x8*)((BASE) + (wr * (MI * 16) + i * 16 + fr) * 144 + ks * 64 + fq * 16); \
    _Pragma("unroll") for (int j = 0; j < 4; ++j) b[j] = *(const bf16x8*)((BASE) + 18432 + (wc * 64 + j * 16 + fr) * 144 + ks * 64 + fq * 16); \
    __builtin_amdgcn_s_setprio(1); \
    _Pragma("unroll") for (int i = 0; i < MI; ++i) \
      _Pragma("unroll") for (int j = 0; j < 4; ++j) acc[i][j] = __builtin_amdgcn_mfma_f32_16x16x32_bf16(b[j], a[i], acc[i][j], 0, 0, 0); \
    __builtin_amdgcn_s_setprio(0); \
  }
  G_LOAD(p, 0)
  const int swoff = srow * 144 + scol * 2;
  __syncthreads();
  G_STORE(p, smem)
  G_LOAD(p, 64)
  __syncthreads();
  for (int kt = 0; kt < 16; kt += 2) {
    const int k2 = (kt + 2 < 16 ? kt + 2 : 15) * 64, k3 = (kt + 3 < 16 ? kt + 3 : 15) * 64;
    G_LOAD(q, k2)
    __builtin_amdgcn_sched_barrier(0);
    G_COMPUTE(smem)
    __builtin_amdgcn_sched_barrier(0);
    G_STORE(p, smem + 36864)
    __syncthreads();
    G_LOAD(p, k3)
    __builtin_amdgcn_sched_barrier(0);
    G_COMPUTE(smem + 36864)
    __builtin_amdgcn_sched_barrier(0);
    G_STORE(q, smem)
    __syncthreads();
  }
#undef G_LOAD
#undef G_STORE
#undef G_COMPUTE
#pragma unroll
  for (int i = 0; i < MI; ++i)
#pragma unroll
    for (int j = 0; j < 4; ++j) epi(m0 + wr * (MI * 16) + i * 16 + fr, n0 + wc * 64 + j * 16 + fq * 4, acc[i][j]);
}

#define LDS3 __attribute__((address_space(3)))
template <class Epi>
DEVI void gemm128g(const bf16_t* __restrict__ A, const bf16_t* __restrict__ Bt, int m0, int n0, char* smem, Epi epi) {
  const int tid = TID(), lane = tid & 63, wid = __builtin_amdgcn_readfirstlane(tid >> 6), wr = wid >> 1, wc = wid & 1, fr = lane & 15, fq = lane >> 4;
  f32x4 acc[4][4];
#pragma unroll
  for (int i = 0; i < 4; ++i)
#pragma unroll
    for (int j = 0; j < 4; ++j) acc[i][j] = f32x4{0.f, 0.f, 0.f, 0.f};
  const int rr = lane >> 2, cchunk = (lane & 3) ^ ((0x78 >> (2 * ((rr >> 2) & 3))) & 3);
  const bf16_t* gA0 = A + (size_t)(m0 + wid * 32 + rr) * 1024 + cchunk * 8;
  const bf16_t* gB0 = Bt + (size_t)(n0 + wid * 32 + rr) * 1024 + cchunk * 8;
  const int segA = wid * 2048, segB = 8192 + wid * 2048;
#define GL_ISSUE(KT) { const int s_ = ((KT) & 3) * 16384; const int ko_ = ((KT) < 31 ? (KT) : 31) * 32; \
    __builtin_amdgcn_global_load_lds((const unsigned*)(gA0 + ko_), (LDS3 unsigned*)(smem + s_ + segA), 16, 0, 0); \
    __builtin_amdgcn_global_load_lds((const unsigned*)(gA0 + ko_ + 16 * 1024), (LDS3 unsigned*)(smem + s_ + segA + 1024), 16, 0, 0); \
    __builtin_amdgcn_global_load_lds((const unsigned*)(gB0 + ko_), (LDS3 unsigned*)(smem + s_ + segB), 16, 0, 0); \
    __builtin_amdgcn_global_load_lds((const unsigned*)(gB0 + ko_ + 16 * 1024), (LDS3 unsigned*)(smem + s_ + segB + 1024), 16, 0, 0); }
  const int swz = (0x78 >> (2 * ((fr >> 2) & 3))) & 3;
  const int rdA = (wr * 64 + fr) * 64 + ((fq ^ swz) * 16);
  const int rdB = 8192 + (wc * 64 + fr) * 64 + ((fq ^ swz) * 16);
  __syncthreads();
  GL_ISSUE(0) GL_ISSUE(1) GL_ISSUE(2)
#pragma unroll 1
  for (int kt = 0; kt < 32; ++kt) {
    asm volatile("s_waitcnt vmcnt(8)" ::: "memory");
    __builtin_amdgcn_s_barrier();
    GL_ISSUE(kt + 3)
    const char* st = smem + (kt & 3) * 16384;
    bf16x8 a[4], b[4];
#pragma unroll
    for (int i = 0; i < 4; ++i) a[i] = *(const bf16x8*)(st + rdA + i * 1024);
#pragma unroll
    for (int j = 0; j < 4; ++j) b[j] = *(const bf16x8*)(st + rdB + j * 1024);
    __builtin_amdgcn_s_setprio(1);
#pragma unroll
    for (int i = 0; i < 4; ++i)
#pragma unroll
      for (int j = 0; j < 4; ++j) acc[i][j] = __builtin_amdgcn_mfma_f32_16x16x32_bf16(b[j], a[i], acc[i][j], 0, 0, 0);
    __builtin_amdgcn_s_setprio(0);
  }
  asm volatile("s_waitcnt vmcnt(0)" ::: "memory");
  __syncthreads();
#undef GL_ISSUE
#pragma unroll
  for (int i = 0; i < 4; ++i)
#pragma unroll
    for (int j = 0; j < 4; ++j) epi(m0 + wr * 64 + i * 16 + fr, n0 + wc * 64 + j * 16 + fq * 4, acc[i][j]);
}

template <class Epi>
DEVI void gemm256g(const bf16_t* __restrict__ A, const bf16_t* __restrict__ Bt, int m0, int n0, char* smem, Epi epi,
                    bf16_t* __restrict__ sout = nullptr, int ldo = 0, int n_staged = 0) {
  const int tid = TID(), lane = tid & 63, wid = __builtin_amdgcn_readfirstlane(tid >> 6), wr = wid >> 1, wc = wid & 1, fr = lane & 15, fq = lane >> 4;
  f32x4 acc[8][4];
#pragma unroll
  for (int i = 0; i < 8; ++i)
#pragma unroll
    for (int j = 0; j < 4; ++j) acc[i][j] = f32x4{0.f, 0.f, 0.f, 0.f};
  const int rr = lane >> 2, cchunk = (lane & 3) ^ ((0x78 >> (2 * ((rr >> 2) & 3))) & 3);
  const bf16_t* gA0 = A + (size_t)(m0 + wid * 64 + rr) * 1024 + cchunk * 8;
  const bf16_t* gB0 = Bt + (size_t)(n0 + wid * 32 + rr) * 1024 + cchunk * 8;
  const int segA = wid * 4096, segB = 16384 + wid * 2048;
#define GL2_ISSUE(KT, ST) { const int s_ = (ST) * 24576; const int ko_ = ((KT) < 31 ? (KT) : 31) * 32; \
    __builtin_amdgcn_global_load_lds((const unsigned*)(gA0 + ko_), (LDS3 unsigned*)(smem + s_ + segA), 16, 0, 0); \
    __builtin_amdgcn_global_load_lds((const unsigned*)(gA0 + ko_ + 16 * 1024), (LDS3 unsigned*)(smem + s_ + segA + 1024), 16, 0, 0); \
    __builtin_amdgcn_global_load_lds((const unsigned*)(gA0 + ko_ + 32 * 1024), (LDS3 unsigned*)(smem + s_ + segA + 2048), 16, 0, 0); \
    __builtin_amdgcn_global_load_lds((const unsigned*)(gA0 + ko_ + 48 * 1024), (LDS3 unsigned*)(smem + s_ + segA + 3072), 16, 0, 0); \
    __builtin_amdgcn_global_load_lds((const unsigned*)(gB0 + ko_), (LDS3 unsigned*)(smem + s_ + segB), 16, 0, 0); \
    __builtin_amdgcn_global_load_lds((const unsigned*)(gB0 + ko_ + 16 * 1024), (LDS3 unsigned*)(smem + s_ + segB + 1024), 16, 0, 0); }
  const int swz = (0x78 >> (2 * ((fr >> 2) & 3))) & 3;
  const int rdA = (wr * 128 + fr) * 64 + ((fq ^ swz) * 16);
  const int rdB = 16384 + (wc * 64 + fr) * 64 + ((fq ^ swz) * 16);
  __syncthreads();
  GL2_ISSUE(0, 0) GL2_ISSUE(1, 1)
  int stc = 0;
#pragma unroll 1
  for (int kt = 0; kt < 32; ++kt) {
    asm volatile("s_waitcnt vmcnt(6)" ::: "memory");
    __builtin_amdgcn_s_barrier();
    { const int stn = stc == 0 ? 2 : stc - 1; GL2_ISSUE(kt + 2, stn) }
    const char* st = smem + stc * 24576;
    bf16x8 b[4];
#pragma unroll
    for (int j = 0; j < 4; ++j) b[j] = *(const bf16x8*)(st + rdB + j * 1024);
    __builtin_amdgcn_s_setprio(1);
#pragma unroll
    for (int i = 0; i < 8; ++i) {
      bf16x8 a = *(const bf16x8*)(st + rdA + i * 1024);
#pragma unroll
      for (int j = 0; j < 4; ++j) acc[i][j] = __builtin_amdgcn_mfma_f32_16x16x32_bf16(b[j], a, acc[i][j], 0, 0, 0);
    }
    __builtin_amdgcn_s_setprio(0);
    stc = stc == 2 ? 0 : stc + 1;
  }
  asm volatile("s_waitcnt vmcnt(0)" ::: "memory");
  __syncthreads();
#undef GL2_ISSUE
  if (sout != nullptr && n0 < n_staged) {
#pragma unroll
    for (int i = 0; i < 8; ++i)
#pragma unroll
      for (int j = 0; j < 4; ++j) *(uint2*)(smem + (wr * 128 + i * 16 + fr) * 272 + (wc * 64 + j * 16 + fq * 4) * 2) = pack4(acc[i][j]);
    __syncthreads();
#pragma unroll 4
    for (int it = 0; it < 16; ++it) {
      const int c = tid + it * 256, row = c >> 4, c16 = c & 15;
      *(uint4*)(sout + (size_t)(m0 + row) * ldo + n0 + c16 * 8) = *(const uint4*)(smem + row * 272 + c16 * 16);
    }
    return;
  }
#pragma unroll
  for (int i = 0; i < 8; ++i)
#pragma unroll
    for (int j = 0; j < 4; ++j) epi(m0 + wr * 128 + i * 16 + fr, n0 + wc * 64 + j * 16 + fq * 4, acc[i][j]);
}

template <class Epi>
DEVI void gemm128(const bf16_t* __restrict__ A, const bf16_t* __restrict__ Bt, int m0, int n0, char* smem, Epi epi) { gemm_t<4>(A, Bt, m0, n0, smem, epi); }
template <class Epi>
DEVI void gemm96(const bf16_t* __restrict__ A, const bf16_t* __restrict__ Bt, int m0, int n0, char* smem, Epi epi) { gemm_t<3>(A, Bt, m0, n0, smem, epi); }

DEVI void transpose_tile(const float* __restrict__ src, int N, int k0, int n0, bf16_t* __restrict__ dst, int dstrow0, char* smem) {
  float* t = (float*)smem;
  const int tid = TID();
  __syncthreads();
#pragma unroll
  for (int i = 0; i < 8; ++i) {
    int kk = (tid >> 5) + i * 8, nn = tid & 31;
    t[kk * 33 + nn] = src[(size_t)(k0 + kk) * N + n0 + nn];
  }
  __syncthreads();
  int nn = tid >> 3, ks = (tid & 7) * 8;
  float v[8];
#pragma unroll
  for (int j = 0; j < 8; ++j) v[j] = t[(ks + j) * 33 + nn];
  uint4 o;
  o.x = pack2(v[0], v[1]); o.y = pack2(v[2], v[3]); o.z = pack2(v[4], v[5]); o.w = pack2(v[6], v[7]);
  *(uint4*)(dst + (size_t)(dstrow0 + nn) * 1024 + k0 + ks) = o;
}

struct Tile8 { uint4 v0, v1, v2, v3, v4, v5, v6, v7; };
DEVI Tile8 tile_load(const bf16_t* __restrict__ src, int ld, int tid) {
  Tile8 t;
  const bf16_t* s0 = src + (size_t)(tid >> 4) * ld + (tid & 15) * 8;
  t.v0 = *(const uint4*)(s0); t.v1 = *(const uint4*)(s0 + (size_t)16 * ld); t.v2 = *(const uint4*)(s0 + (size_t)32 * ld); t.v3 = *(const uint4*)(s0 + (size_t)48 * ld);
  t.v4 = *(const uint4*)(s0 + (size_t)64 * ld); t.v5 = *(const uint4*)(s0 + (size_t)80 * ld); t.v6 = *(const uint4*)(s0 + (size_t)96 * ld); t.v7 = *(const uint4*)(s0 + (size_t)112 * ld);
  return t;
}
DEVI void tile_put_T1(bf16_t* dst, const uint4& u, int row, int c8, const float* scale) {
  unsigned w[4] = {u.x, u.y, u.z, u.w};
  if (scale) {
    float s = scale[row];
#pragma unroll
    for (int j = 0; j < 4; ++j) {
      dst[(c8 + 2 * j) * 136 + row] = f2bf(lo2f(w[j]) * s);
      dst[(c8 + 2 * j + 1) * 136 + row] = f2bf(hi2f(w[j]) * s);
    }
  } else {
#pragma unroll
    for (int j = 0; j < 4; ++j) {
      dst[(c8 + 2 * j) * 136 + row] = (bf16_t)(w[j] & 0xFFFF);
      dst[(c8 + 2 * j + 1) * 136 + row] = (bf16_t)(w[j] >> 16);
    }
  }
}
DEVI void tile_put_T(char* dstb, const Tile8& t, int tid, const float* scale) {
  bf16_t* dst = (bf16_t*)dstb;
  const int row = tid >> 4, c8 = (tid & 15) * 8;
  tile_put_T1(dst, t.v0, row, c8, scale); tile_put_T1(dst, t.v1, row + 16, c8, scale); tile_put_T1(dst, t.v2, row + 32, c8, scale); tile_put_T1(dst, t.v3, row + 48, c8, scale);
  tile_put_T1(dst, t.v4, row + 64, c8, scale); tile_put_T1(dst, t.v5, row + 80, c8, scale); tile_put_T1(dst, t.v6, row + 96, c8, scale); tile_put_T1(dst, t.v7, row + 112, c8, scale);
}
struct TileT { uint4 a0, a1, a2, a3, b0, b1, b2, b3; };
DEVI TileT tile_loadT(const bf16_t* __restrict__ src, int ld, int tid) {
  TileT t;
  const bf16_t* s0 = src + (size_t)((tid & 63) * 2) * ld + (tid >> 6) * 32;
  const bf16_t* s1 = s0 + ld;
  t.a0 = *(const uint4*)(s0); t.a1 = *(const uint4*)(s0 + 8); t.a2 = *(const uint4*)(s0 + 16); t.a3 = *(const uint4*)(s0 + 24);
  t.b0 = *(const uint4*)(s1); t.b1 = *(const uint4*)(s1 + 8); t.b2 = *(const uint4*)(s1 + 16); t.b3 = *(const uint4*)(s1 + 24);
  return t;
}
DEVI void tile_putT_chunk(unsigned* dst, const uint4& ua, const uint4& ub, int cbase, int rp, bool scaled, float sa, float sb) {
  const unsigned wa[4] = {ua.x, ua.y, ua.z, ua.w}, wb[4] = {ub.x, ub.y, ub.z, ub.w};
#pragma unroll
  for (int k = 0; k < 4; ++k) {
    unsigned lo, hi;
    if (scaled) { lo = pack2(lo2f(wa[k]) * sa, lo2f(wb[k]) * sb); hi = pack2(hi2f(wa[k]) * sa, hi2f(wb[k]) * sb); }
    else { lo = (wa[k] & 0xFFFFu) | (wb[k] << 16); hi = (wa[k] >> 16) | (wb[k] & 0xFFFF0000u); }
    dst[(cbase + 2 * k) * 68 + rp] = lo;
    dst[(cbase + 2 * k + 1) * 68 + rp] = hi;
  }
}
DEVI void tile_putT2(char* dstb, const TileT& t, int tid, const float* scale) {
  unsigned* dst = (unsigned*)dstb;
  const int rp = tid & 63, c0 = (tid >> 6) * 32;
  const bool scaled = scale != nullptr;
  float sa = 1.f, sb = 1.f;
  if (scaled) { sa = scale[2 * rp]; sb = scale[2 * rp + 1]; }
  tile_putT_chunk(dst, t.a0, t.b0, c0, rp, scaled, sa, sb);
  tile_putT_chunk(dst, t.a1, t.b1, c0 + 8, rp, scaled, sa, sb);
  tile_putT_chunk(dst, t.a2, t.b2, c0 + 16, rp, scaled, sa, sb);
  tile_putT_chunk(dst, t.a3, t.b3, c0 + 24, rp, scaled, sa, sb);
}
DEVI void tile_put_R(char* dstb, const Tile8& t, int tid) {
  char* d = dstb + (tid >> 4) * 272 + (tid & 15) * 16;
  *(uint4*)(d) = t.v0; *(uint4*)(d + 16 * 272) = t.v1; *(uint4*)(d + 32 * 272) = t.v2; *(uint4*)(d + 48 * 272) = t.v3;
  *(uint4*)(d + 64 * 272) = t.v4; *(uint4*)(d + 80 * 272) = t.v5; *(uint4*)(d + 96 * 272) = t.v6; *(uint4*)(d + 112 * 272) = t.v7;
}
DEVI void stage_T(char* dstb, const bf16_t* __restrict__ src, int ld, const float* scale) {
  const int tid = TID();
  Tile8 t = tile_load(src, ld, tid);
  tile_put_T(dstb, t, tid, scale);
}
DEVI void stage_R(char* dstb, const bf16_t* __restrict__ src, int ld) {
  const int tid = TID();
  Tile8 t = tile_load(src, ld, tid);
  tile_put_R(dstb, t, tid);
}

DEVI void mma_regA(const bf16x8 (&a)[2][4], const char* B, f32x4 (&acc)[2][8], int fr, int fq) {
#pragma unroll
  for (int ks = 0; ks < 4; ++ks) {
#pragma unroll
    for (int nt = 0; nt < 8; ++nt) {
      bf16x8 b = *(const bf16x8*)(B + (nt * 16 + fr) * 272 + ks * 64 + fq * 16);
#pragma unroll
      for (int mt = 0; mt < 2; ++mt) acc[mt][nt] = __builtin_amdgcn_mfma_f32_16x16x32_bf16(b, a[mt][ks], acc[mt][nt], 0, 0, 0);
    }
    asm volatile("" ::: "memory");
  }
}
DEVI void load_fragA(bf16x8 (&a)[2][4], const char* A, int rowbase, int fr, int fq) {
#pragma unroll
  for (int mt = 0; mt < 2; ++mt)
#pragma unroll
    for (int ks = 0; ks < 4; ++ks) a[mt][ks] = *(const bf16x8*)(A + (rowbase + mt * 16 + fr) * 272 + ks * 64 + fq * 16);
}

DEVI void phase_mod(const Params& p, char* smem) {
  float* s = (float*)smem;
  float* red = s + 3072;
  const int tid = TID();
  for (int i = tid; i < 1024; i += 256) {
    s[i] = silu_f(p.c[i]);
    s[1024 + i] = silu_f(p.c[1024 + i]);
    s[2048 + i] = silu_f(p.c_ctx[i]);
  }
  __syncthreads();
  const int kg = tid >> 6, col = tid & 63;
  for (int item = BID(); item < 4 * 96; item += gridDim.x) {
    int l = item / 96, cb = item % 96, n = cb * 64 + col;
    const float* W = p.w_mod + (size_t)l * 1024 * 6144 + n;
    float a0 = 0, a1 = 0, a2 = 0;
#pragma unroll 32
    for (int k = kg * 256; k < kg * 256 + 256; ++k) {
      float w = W[(size_t)k * 6144];
      a0 += s[k] * w; a1 += s[1024 + k] * w; a2 += s[2048 + k] * w;
    }
    red[(kg * 3 + 0) * 64 + col] = a0; red[(kg * 3 + 1) * 64 + col] = a1; red[(kg * 3 + 2) * 64 + col] = a2;
    __syncthreads();
    if (tid < 192) {
      int i = tid >> 6;
      float v = red[(0 * 3 + i) * 64 + col] + red[(1 * 3 + i) * 64 + col] + red[(2 * 3 + i) * 64 + col] + red[(3 * 3 + i) * 64 + col];
      p.mod[((size_t)l * 3 + i) * 6144 + n] = v + p.b_mod[l * 6144 + n];
    }
    __syncthreads();
  }
}

DEVI void phase_prep(const Params& p, int l, char* smem) {
  const int tid = TID();
  const int n_in = 257 * 16, n_sq = 32 * 16, n_q = 64 * 16;
  const int total = n_in + 3 * n_sq + n_q;
  for (int item = BID(); item < total; item += gridDim.x) {
    int it = item;
    if (it < n_in) {
      int nt = it >> 4, kt = it & 15, n0 = nt * 32;
      int d0 = n0 < 4096 ? n0 : (n0 < 4128 ? n0 + 4096 : n0 - 32);
      transpose_tile(p.w_in + (size_t)l * 1024 * INW, INW, kt * 64, n0, p.wt_in, d0, smem);
    } else if ((it -= n_in) < 3 * n_sq) {
      int which = it / n_sq; it %= n_sq;
      int nt = it >> 4, kt = it & 15;
      const float* src = (which == 0 ? p.p_a : which == 1 ? p.p_b : p.w_out) + (size_t)l * 1024 * 1024;
      bf16_t* dst = which == 0 ? p.wt_pa : which == 1 ? p.wt_pb : p.wt_out;
      transpose_tile(src, 1024, kt * 64, nt * 32, dst, nt * 32, smem);
    } else {
      it -= 3 * n_sq;
      int nt = it >> 4, kt = it & 15;
      transpose_tile(p.peer_wq + (size_t)l * 1024 * 2048, 2048, kt * 64, nt * 32, p.wt_q, nt * 32, smem);
    }
  }
  const size_t gtid = (size_t)BID() * 256 + tid, gstride = (size_t)gridDim.x * 256;
  for (size_t i = gtid; i < (size_t)(INWP - INW) * 1024 / 8; i += gstride) ((uint4*)(p.wt_in + (size_t)INW * 1024))[i] = uint4{0, 0, 0, 0};
  {
    const int lane = tid & 63;
    const int gw = (int)(gtid >> 6), nw = (int)(gstride >> 6);
    for (int row = gw; row < 32768; row += nw) {
      const int e = row & 16383, which = row >> 14;
      const float* src = (which ? p.expert_v : p.expert_u) + ((size_t)l * 16384 + e) * 1024 + lane * 16;
      float4 a0 = *(const float4*)(src), a1 = *(const float4*)(src + 4), a2 = *(const float4*)(src + 8), a3 = *(const float4*)(src + 12);
      float am = fmaxf(fmaxf(fmaxf(fabsf(a0.x), fabsf(a0.y)), fmaxf(fabsf(a0.z), fabsf(a0.w))), fmaxf(fmaxf(fabsf(a1.x), fabsf(a1.y)), fmaxf(fabsf(a1.z), fabsf(a1.w))));
      am = fmaxf(am, fmaxf(fmaxf(fmaxf(fabsf(a2.x), fabsf(a2.y)), fmaxf(fabsf(a2.z), fabsf(a2.w))), fmaxf(fmaxf(fabsf(a3.x), fabsf(a3.y)), fmaxf(fabsf(a3.z), fabsf(a3.w)))));
#pragma unroll
      for (int o = 32; o > 0; o >>= 1) am = fmaxf(am, __shfl_xor(am, o));
      const float sc = am > 0.f ? am * (1.f / 440.f) : 1.f, inv = 1.f / sc;
      int w0 = 0, w1 = 0, w2 = 0, w3 = 0;
      w0 = __builtin_amdgcn_cvt_pk_fp8_f32(a0.x * inv, a0.y * inv, w0, false); w0 = __builtin_amdgcn_cvt_pk_fp8_f32(a0.z * inv, a0.w * inv, w0, true);
      w1 = __builtin_amdgcn_cvt_pk_fp8_f32(a1.x * inv, a1.y * inv, w1, false); w1 = __builtin_amdgcn_cvt_pk_fp8_f32(a1.z * inv, a1.w * inv, w1, true);
      w2 = __builtin_amdgcn_cvt_pk_fp8_f32(a2.x * inv, a2.y * inv, w2, false); w2 = __builtin_amdgcn_cvt_pk_fp8_f32(a2.z * inv, a2.w * inv, w2, true);
      w3 = __builtin_amdgcn_cvt_pk_fp8_f32(a3.x * inv, a3.y * inv, w3, false); w3 = __builtin_amdgcn_cvt_pk_fp8_f32(a3.z * inv, a3.w * inv, w3, true);
      unsigned char* dst = (which ? p.ev : p.eu) + (size_t)(l & 1) * 16384 * 1024 + (size_t)e * 1024 + lane * 16;
      *(uint4*)dst = uint4{(unsigned)w0, (unsigned)w1, (unsigned)w2, (unsigned)w3};
      if (lane == 0) p.escale[(l & 1) * 32768 + which * 16384 + e] = sc;
    }
  }
  {
    const float* sk = p.peer_keys + (size_t)l * 262144;
    for (size_t i = gtid; i < 262144; i += gstride) p.keys[(size_t)(l & 1) * 262144 + i] = f2bf(sk[i]);
  }
  if (l == 0) {
    for (size_t i = gtid; i < (size_t)NT * 256; i += gstride) {
      int tok = (int)(i >> 8), d = (int)(i & 255) * 4;
      float4 v = tok < NTX ? *(const float4*)(p.x + (size_t)tok * 1024 + d) : *(const float4*)(p.ctx + (size_t)(tok - NTX) * 1024 + d);
      *(float4*)(p.z + (size_t)tok * 1024 + d) = v;
      const float* m = p.mod + (size_t)mod_index(tok) * 6144;
      float h0 = v.x * (1.f + m[1024 + d]) + m[d], h1 = v.y * (1.f + m[1024 + d + 1]) + m[d + 1];
      float h2 = v.z * (1.f + m[1024 + d + 2]) + m[d + 2], h3 = v.w * (1.f + m[1024 + d + 3]) + m[d + 3];
      uint2 o; o.x = pack2(h0, h1); o.y = pack2(h2, h3);
      *(uint2*)(p.h + (size_t)tok * 1024 + d) = o;
    }
  }
}

DEVI bool xcd_tile(int it, int nM, int nN, int& mt, int& nt) {
  const int b = BID(), per = gridDim.x >> 3;
  const int t = (it * 8 + (b & 7)) * per + (b >> 3);
  if (t >= nM * nN) return false;
  const int width = 8 * nN, g = t / width, first_m = g * 8;
  const int gsz = min(nM - first_m, 8), tt = t - g * width;
  mt = first_m + tt % gsz; nt = tt / gsz;
  return true;
}

DEVI void phase_g1(const Params& p, int l, char* smem) {
  const int nM256 = 63, nM128 = (NT - 63 * 256) / 128, nN = INWP / 128;
  bf16_t* proj = p.proj; float* gates = p.gates; const float* gate_b = p.gate_b + l * 32;
  auto epi = [&](int m, int n, const f32x4& v) {
    if (n < 8192) *(uint2*)(proj + (size_t)m * 8192 + n) = pack4(v);
    else if (n < 8224) *(f32x4*)(gates + m * 32 + (n - 8192)) = v + *(const f32x4*)(gate_b + (n - 8192));
  };
  for (int it = 0;; ++it) {
    int mt, nt;
    if (!xcd_tile(it, nM256, nN, mt, nt)) break;
    gemm256g(p.h, p.wt_in, mt * 256, nt * 128, smem, epi, proj, 8192, 8192);
  }
  for (int it = 0;; ++it) {
    int mt, nt;
    if (!xcd_tile(it, nM128, nN, mt, nt)) break;
    gemm128g(p.h, p.wt_in, nM256 * 256 + mt * 128, nt * 128, smem, epi);
  }
}

DEVI void conv_tap(float (&acc)[8], const uint4& u, const float4& w0, const float4& w1) {
  acc[0] += lo2f(u.x) * w0.x; acc[1] += hi2f(u.x) * w0.y; acc[2] += lo2f(u.y) * w0.z; acc[3] += hi2f(u.y) * w0.w;
  acc[4] += lo2f(u.z) * w1.x; acc[5] += hi2f(u.z) * w1.y; acc[6] += lo2f(u.w) * w1.z; acc[7] += hi2f(u.w) * w1.w;
}
DEVI void phase_conv(const Params& p, int l, char* smem) {
  const int tid = TID();
  const size_t gtid = (size_t)BID() * 256 + tid, gstride = (size_t)gridDim.x * 256;
  const float* cw = p.qk_conv_w + (size_t)l * 9 * 2048;
  const float* cb = p.qk_conv_b + (size_t)l * 2048;
  const bf16_t* __restrict__ proj = p.proj;
  for (size_t i = gtid; i < (size_t)256 * 2 * 256; i += gstride) {
    const int cg = (int)(i & 255), seg = (int)((i >> 8) & 1), grow = (int)(i >> 9), b = grow >> 7, r = grow & 127, ch = cg * 8;
    float4 w[9][2];
#pragma unroll
    for (int t = 0; t < 9; ++t) { w[t][0] = *(const float4*)(cw + t * 2048 + ch); w[t][1] = *(const float4*)(cw + t * 2048 + ch + 4); }
    const float4 b0 = *(const float4*)(cb + ch), b1 = *(const float4*)(cb + ch + 4);
    const bool v0 = r > 0, v2 = r < 127;
    const bf16_t* row1 = proj + (size_t)(b * 8192 + r * 64) * 8192 + ch;
    const bf16_t* row0 = row1 - (size_t)64 * 8192;
    const bf16_t* row2 = row1 + (size_t)64 * 8192;
    const uint4 zz = uint4{0, 0, 0, 0};
    const int c0 = seg * 32;
    uint4 L0 = zz, L1 = zz, L2 = zz, M0, M1, M2;
    if (c0 > 0) {
      L0 = v0 ? *(const uint4*)(row0 + (size_t)(c0 - 1) * 8192) : zz;
      L1 = *(const uint4*)(row1 + (size_t)(c0 - 1) * 8192);
      L2 = v2 ? *(const uint4*)(row2 + (size_t)(c0 - 1) * 8192) : zz;
    }
    M0 = v0 ? *(const uint4*)(row0 + (size_t)c0 * 8192) : zz;
    M1 = *(const uint4*)(row1 + (size_t)c0 * 8192);
    M2 = v2 ? *(const uint4*)(row2 + (size_t)c0 * 8192) : zz;
    const float sc = ch < 1024 ? 0.08838834764831845f : 1.f;
    bf16_t* dst = (ch < 1024 ? p.q + ch : p.k + (ch - 1024)) + (size_t)(b * 8192 + r * 64) * 1024;
#pragma unroll 1
    for (int cc = c0; cc < c0 + 32; cc += 4) {
      uint4 R0[4], R1[4], R2[4];
#pragma unroll
      for (int j = 0; j < 4; ++j) {
        const int cn = cc + j + 1;
        const bool vc = cn < 64;
        R0[j] = (vc && v0) ? *(const uint4*)(row0 + (size_t)cn * 8192) : zz;
        R1[j] = vc ? *(const uint4*)(row1 + (size_t)cn * 8192) : zz;
        R2[j] = (vc && v2) ? *(const uint4*)(row2 + (size_t)cn * 8192) : zz;
      }
#pragma unroll
      for (int j = 0; j < 4; ++j) {
        float acc[8] = {b0.x, b0.y, b0.z, b0.w, b1.x, b1.y, b1.z, b1.w};
        conv_tap(acc, L0, w[0][0], w[0][1]); conv_tap(acc, M0, w[1][0], w[1][1]); conv_tap(acc, R0[j], w[2][0], w[2][1]);
        conv_tap(acc, L1, w[3][0], w[3][1]); conv_tap(acc, M1, w[4][0], w[4][1]); conv_tap(acc, R1[j], w[5][0], w[5][1]);
        conv_tap(acc, L2, w[6][0], w[6][1]); conv_tap(acc, M2, w[7][0], w[7][1]); conv_tap(acc, R2[j], w[8][0], w[8][1]);
#pragma unroll
        for (int q = 0; q < 8; ++q) acc[q] = silu_f(acc[q]) * sc;
        uint4 o; o.x = pack2(acc[0], acc[1]); o.y = pack2(acc[2], acc[3]); o.z = pack2(acc[4], acc[5]); o.w = pack2(acc[6], acc[7]);
        *(uint4*)(dst + (size_t)(cc + j) * 1024) = o;
        L0 = M0; L1 = M1; L2 = M2; M0 = R0[j]; M1 = R1[j]; M2 = R2[j];
      }
    }
  }
  for (size_t i = (size_t)NTX * 256 + gtid; i < (size_t)NT * 256; i += gstride) {
    int tok = (int)(i >> 8), ch = (int)(i & 255) * 8;
    float acc[8];
#pragma unroll
    for (int j = 0; j < 8; ++j) acc[j] = cb[ch + j];
    int t = (tok - NTX) & 255;
#pragma unroll
    for (int dj = 0; dj < 3; ++dj) {
      int tt = t + dj - 1;
      if (tt >= 0 && tt < 256) {
        uint4 u = *(const uint4*)(p.proj + (size_t)(tok + dj - 1) * 8192 + ch);
        const float* w = cw + (3 + dj) * 2048 + ch;
        conv_tap(acc, u, *(const float4*)w, *(const float4*)(w + 4));
      }
    }
    float sc = ch < 1024 ? 0.08838834764831845f : 1.f;
#pragma unroll
    for (int j = 0; j < 8; ++j) acc[j] = silu_f(acc[j]) * sc;
    uint4 o; o.x = pack2(acc[0], acc[1]); o.y = pack2(acc[2], acc[3]); o.z = pack2(acc[4], acc[5]); o.w = pack2(acc[6], acc[7]);
    if (ch < 1024) *(uint4*)(p.q + (size_t)tok * 1024 + ch) = o;
    else *(uint4*)(p.k + (size_t)tok * 1024 + ch - 1024) = o;
  }
  const int lane = tid & 63;
  const int gw = (BID() * 256 + tid) >> 6, nw = gridDim.x * 4;
  for (int tok = gw; tok < NT; tok += nw) {
    const bf16_t* src = p.proj + (size_t)tok * 8192 + 5120;
    uint4 u0 = *(const uint4*)(src + lane * 8), u1 = *(const uint4*)(src + 512 + lane * 8);
    unsigned w[8] = {u0.x, u0.y, u0.z, u0.w, u1.x, u1.y, u1.z, u1.w};
    float g[16]; float s = 0.f;
#pragma unroll
    for (int j = 0; j < 8; ++j) { g[2 * j] = gelu_f(lo2f(w[j])); g[2 * j + 1] = gelu_f(hi2f(w[j])); s += g[2 * j] + g[2 * j + 1]; }
    float mu = wave_sum(s) * (1.f / 1024.f);
    float v = 0.f;
#pragma unroll
    for (int j = 0; j < 16; ++j) { float d = g[j] - mu; v += d * d; }
    v = wave_sum(v) * (1.f / 1024.f);
    if (lane == 0) { p.sgu_stats[tok * 2] = mu; p.sgu_stats[tok * 2 + 1] = rsqrtf(v + LN_EPS); }
  }
}

DEVI void store_acc_bf16(bf16_t* dst, const f32x4 (&acc)[2][8], int rowbase, int fr, int fq) {
#pragma unroll
  for (int mt = 0; mt < 2; ++mt)
#pragma unroll
    for (int nt = 0; nt < 8; ++nt) *(uint2*)(dst + (rowbase + mt * 16 + fr) * 128 + nt * 16 + fq * 4) = pack4(acc[mt][nt]);
}

DEVI void mloc_item(const Params& p, int item, char* smem) {
  int tid_ = TID(); asm volatile("" : "+v"(tid_));
  const int tid = tid_, lane = tid & 63, wid = tid >> 6, fr = lane & 15, fq = lane >> 4;
  const int cidx = item % 66, bh = item / 66, hh = bh & 7, b = bh >> 3;
  const int tok0 = tok_base(b, cidx);
  char* KT = smem; char* VT = smem + 34816;
  float* fa = (float*)(smem + 69632);
  float *fcf = fa, *fif = fa + 128, *fcb = fa + 256, *fib = fa + 384, *bf = fa + 512, *bb = fa + 640, *wlf = fa + 768, *wlb = fa + 896;
  __syncthreads();
  if (tid < 128) {
    const float* g = p.gates + (size_t)(tok0 + tid) * 32;
    fif[tid] = g[hh]; fcf[tid] = logsigmoid_f(g[8 + hh]); fib[tid] = g[16 + hh]; fcb[tid] = logsigmoid_f(g[24 + hh]);
  }
  __syncthreads();
  if (tid < 128) { float s = 0.f;
#pragma unroll 8
    for (int i = 0; i <= tid; ++i) s += fcf[i]; bf[tid] = s; }
  else { int t = tid - 128; float s = 0.f;
#pragma unroll 8
    for (int i = 127; i >= t; --i) s += fcb[i]; bb[t] = s; }
  __syncthreads();
  float gf = bf[127], gb = bb[0], mlf, mlb;
  {
    float m = -3.0e38f;
    if (tid < 128) {
_Pragma("unroll 4")
 for (int i = 0; i < 128; ++i) m = fmaxf(m, gf - bf[i] + fif[i]); wlf[tid] = __expf(gf - bf[tid] + fif[tid] - m); mlf = m; }
    else { int t = tid - 128;
_Pragma("unroll 4")
 for (int i = 0; i < 128; ++i) m = fmaxf(m, gb - bb[i] + fib[i]); wlb[t] = __expf(gb - bb[t] + fib[t] - m); mlb = m; }
  }
  if (tid == 0) { p.cscal[(0 * NITEM + item) * 2] = gf; p.cscal[(0 * NITEM + item) * 2 + 1] = mlf; }
  if (tid == 128) { p.cscal[(1 * NITEM + item) * 2] = gb; p.cscal[(1 * NITEM + item) * 2 + 1] = mlb; }
  __syncthreads();
  const bf16_t* ksrc = p.k + (size_t)tok0 * 1024 + hh * 128;
  const bf16_t* vsrc = p.proj + (size_t)tok0 * 8192 + 2048 + hh * 128;
  {
    TileT tk = tile_loadT(ksrc, 1024, tid);
    tile_putT2(KT, tk, tid, nullptr);
  }
#pragma unroll 1
  for (int dir = 0; dir < 2; ++dir) {
    const float* wl = dir ? wlb : wlf;
    {
      TileT tv = tile_loadT(vsrc, 8192, tid);
      tile_putT2(VT, tv, tid, wl);
    }
    __syncthreads();
    bf16x8 a[2][4];
    load_fragA(a, VT, wid * 32, fr, fq);
    f32x4 acc[2][8];
#pragma unroll
    for (int mt = 0; mt < 2; ++mt)
#pragma unroll
      for (int nt = 0; nt < 8; ++nt) acc[mt][nt] = f32x4{0.f, 0.f, 0.f, 0.f};
    mma_regA(a, KT, acc, fr, fq);
    store_acc_bf16(p.dC + ((size_t)dir * NITEM + item) * 16384, acc, wid * 32, fr, fq);
    if (tid < 128) {
      const bf16_t* kr = (const bf16_t*)KT + tid * 136;
      float s = 0.f;
#pragma unroll 4
      for (int i = 0; i < 128; ++i) s += wl[i] * bf2f(kr[i]);
      p.dn[((size_t)dir * NITEM + item) * 128 + tid] = s;
    }
    __syncthreads();
  }
}

DEVI void sgu_item(const Params& p, int l, int item, char* smem) {
  int tid_ = TID(); asm volatile("" : "+v"(tid_));
  const int tid = tid_, lane = tid & 63, wid = tid >> 6, fr = lane & 15, fq = lane >> 4;
  const int chunk = item >> 3, g = item & 7, tok0 = chunk * 128;
  char* ZT = smem; char* WS = smem + 34816;
  __syncthreads();
  {
    unsigned* dst = (unsigned*)ZT;
    const float* nw = p.sgu_norm_w + l * 1024 + g * 128;
    const int rp = tid & 63, c0 = (tid >> 6) * 32;
    const bf16_t* ra = p.proj + (size_t)(tok0 + 2 * rp) * 8192 + 5120 + g * 128 + c0;
    const float muA = p.sgu_stats[(tok0 + 2 * rp) * 2], rsA = p.sgu_stats[(tok0 + 2 * rp) * 2 + 1];
    const float muB = p.sgu_stats[(tok0 + 2 * rp + 1) * 2], rsB = p.sgu_stats[(tok0 + 2 * rp + 1) * 2 + 1];
#pragma unroll 2
    for (int i = 0; i < 4; ++i) {
      const uint4 ua = *(const uint4*)(ra + i * 8), ub = *(const uint4*)(ra + 8192 + i * 8);
      const unsigned wa[4] = {ua.x, ua.y, ua.z, ua.w}, wb[4] = {ub.x, ub.y, ub.z, ub.w};
#pragma unroll
      for (int k = 0; k < 4; ++k) {
        const int col = c0 + i * 8 + 2 * k;
        const float n0 = nw[col], n1 = nw[col + 1];
        const unsigned lo = pack2((gelu_f(lo2f(wa[k])) - muA) * rsA * n0, (gelu_f(lo2f(wb[k])) - muB) * rsB * n0);
        const unsigned hi = pack2((gelu_f(hi2f(wa[k])) - muA) * rsA * n1, (gelu_f(hi2f(wb[k])) - muB) * rsB * n1);
        dst[col * 68 + rp] = lo;
        dst[(col + 1) * 68 + rp] = hi;
      }
    }
    const float* ws = p.sgu_w + ((size_t)l * 8 + g) * 16384;
#pragma unroll 4
    for (int i = 0; i < 16; ++i) {
      int c = tid + i * 256, row = c >> 5, c4 = (c & 31) * 4;
      float4 v = *(const float4*)(ws + row * 128 + c4);
      uint2 o; o.x = pack2(v.x, v.y); o.y = pack2(v.z, v.w);
      *(uint2*)(WS + row * 272 + c4 * 2) = o;
    }
  }
  __syncthreads();
  bf16x8 a[2][4];
  load_fragA(a, WS, wid * 32, fr, fq);
  f32x4 acc[2][8];
#pragma unroll
  for (int mt = 0; mt < 2; ++mt)
#pragma unroll
    for (int nt = 0; nt < 8; ++nt) acc[mt][nt] = f32x4{0.f, 0.f, 0.f, 0.f};
  mma_regA(a, ZT, acc, fr, fq);
  const float* bs = p.sgu_b + ((size_t)l * 8 + g) * 128;
#pragma unroll
  for (int mt = 0; mt < 2; ++mt) {
    const int pp = wid * 32 + mt * 16 + fr;
    const float bsv = bs[pp];
#pragma unroll
    for (int nt = 0; nt < 8; ++nt) {
      const int cc = g * 128 + nt * 16 + fq * 4;
      f32x4 u = unpack4(*(const uint2*)(p.proj + (size_t)(tok0 + pp) * 8192 + 4096 + cc));
      f32x4 o = f32x4{gelu_f(u[0]), gelu_f(u[1]), gelu_f(u[2]), gelu_f(u[3])} * (acc[mt][nt] + bsv);
      *(uint2*)(p.hB + (size_t)(tok0 + pp) * 1024 + cc) = pack4(o);
    }
  }
}

DEVI void phase_mloc(const Params& p, int l, char* smem) {
  for (int item = BID(); item < 2 * NITEM; item += gridDim.x) {
    if (item < NITEM) mloc_item(p, item, smem);
    else sgu_item(p, l, item - NITEM, smem);
  }
}

DEVI void phase_scan(const Params& p) {
  const size_t gtid = (size_t)BID() * 256 + TID(), gstride = (size_t)gridDim.x * 256;
  for (size_t i = gtid; i < 32 * 2048; i += gstride) {
    int chain = (int)(i >> 11), e = (int)(i & 2047);
    int dir = chain >> 4, bh = chain & 15;
    float C[8];
#pragma unroll
    for (int j = 0; j < 8; ++j) C[j] = 0.f;
    float nacc[8];
#pragma unroll
    for (int j = 0; j < 8; ++j) nacc[j] = 0.f;
    float m = -1e30f;
#pragma unroll 11
    for (int j = 0; j < 66; ++j) {
      int cidx = dir == 0 ? (j < 2 ? 64 + j : j - 2) : (j < 2 ? 65 - j : 65 - j);
      size_t it = (size_t)dir * NITEM + bh * 66 + cidx;
      uint4 o; o.x = pack2(C[0], C[1]); o.y = pack2(C[2], C[3]); o.z = pack2(C[4], C[5]); o.w = pack2(C[6], C[7]);
      *(uint4*)(p.Cin + it * 16384 + e * 8) = o;
      if (e == 0) p.min_[it] = m;
      uint4 u = *(const uint4*)(p.dC + it * 16384 + e * 8);
      float g = p.cscal[it * 2], ml = p.cscal[it * 2 + 1];
      float mn = fmaxf(g + m, ml);
      float a = __expf(g + m - mn), s = __expf(ml - mn);
      C[0] = a * C[0] + s * lo2f(u.x); C[1] = a * C[1] + s * hi2f(u.x);
      C[2] = a * C[2] + s * lo2f(u.y); C[3] = a * C[3] + s * hi2f(u.y);
      C[4] = a * C[4] + s * lo2f(u.z); C[5] = a * C[5] + s * hi2f(u.z);
      C[6] = a * C[6] + s * lo2f(u.w); C[7] = a * C[7] + s * hi2f(u.w);
      if (e < 16) {
        float4 d0 = *(const float4*)(p.dn + it * 128 + e * 8), d1 = *(const float4*)(p.dn + it * 128 + e * 8 + 4);
        *(float4*)(p.nin + it * 128 + e * 8) = float4{nacc[0], nacc[1], nacc[2], nacc[3]};
        *(float4*)(p.nin + it * 128 + e * 8 + 4) = float4{nacc[4], nacc[5], nacc[6], nacc[7]};
        nacc[0] = a * nacc[0] + s * d0.x; nacc[1] = a * nacc[1] + s * d0.y; nacc[2] = a * nacc[2] + s * d0.z; nacc[3] = a * nacc[3] + s * d0.w;
        nacc[4] = a * nacc[4] + s * d1.x; nacc[5] = a * nacc[5] + s * d1.y; nacc[6] = a * nacc[6] + s * d1.z; nacc[7] = a * nacc[7] + s * d1.w;
      }
      m = mn;
    }
  }
}

DEVI bf16x8 scale_frag(bf16x8 a, float s) {
  asm volatile("" : "+v"(a));
  typedef unsigned u32x4_t __attribute__((ext_vector_type(4)));
  u32x4_t w = __builtin_bit_cast(u32x4_t, a), o;
#pragma unroll
  for (int j = 0; j < 4; ++j) o[j] = pack2(lo2f(w[j]) * s, hi2f(w[j]) * s);
  return __builtin_bit_cast(bf16x8, o);
}

DEVI void mout_item(const Params& p, int l, int item, char* smem) {
  int tid_ = TID(); asm volatile("" : "+v"(tid_));
  const int tid = tid_, lane = tid & 63, wid = tid >> 6, fr = lane & 15, fq = lane >> 4;
  const int cidx = item % 66, bh = item / 66, hh = bh & 7, b = bh >> 3;
  const int tok0 = tok_base(b, cidx);
  char* B0 = smem; char* B1 = smem + 34816;
  float* fa = (float*)(smem + 69632);
  float *fcf = fa, *fif = fa + 128, *fcb = fa + 256, *fib = fa + 384, *bfv = fa + 512, *bbv = fa + 640, *ef = fa + 768, *eb = fa + 896,
        *mtf = fa + 1024, *mtb = fa + 1152, *af = fa + 1280, *ab = fa + 1408, *qnf = fa + 1536, *qnb = fa + 1664, *cf = fa + 1792, *cb = fa + 1920;
  float* nf = fa + 2048 - 0;
  float* nb = nf + 128;
  __syncthreads();
  const size_t itf = (size_t)0 * NITEM + item, itb = (size_t)1 * NITEM + item;
  if (tid < 128) {
    const float* g = p.gates + (size_t)(tok0 + tid) * 32;
    fif[tid] = g[hh]; fcf[tid] = logsigmoid_f(g[8 + hh]); fib[tid] = g[16 + hh]; fcb[tid] = logsigmoid_f(g[24 + hh]);
    nf[tid] = p.nin[itf * 128 + tid]; nb[tid] = p.nin[itb * 128 + tid];
  }
  bf16x8 qa[2][4];
  {
    const bf16_t* qsrc = p.q + (size_t)tok0 * 1024 + hh * 128;
#pragma unroll
    for (int mt = 0; mt < 2; ++mt)
#pragma unroll
      for (int ks = 0; ks < 4; ++ks) qa[mt][ks] = *(const bf16x8*)(qsrc + (size_t)(wid * 32 + mt * 16 + fr) * 1024 + ks * 32 + fq * 8);
  }
  {
    Tile8 tk = tile_load(p.k + (size_t)tok0 * 1024 + hh * 128, 1024, tid);
    TileT tv = tile_loadT(p.proj + (size_t)tok0 * 8192 + 2048 + hh * 128, 8192, tid);
    tile_put_R(B0, tk, tid);
    tile_putT2(B1, tv, tid, nullptr);
  }
  const float m_f = p.min_[itf], m_b = p.min_[itb];
  __syncthreads();
  if (tid < 128) {
    float run = 0.f, pm = -3.0e38f, e = 0.f;
#pragma unroll 8
    for (int i = 0; i <= tid; ++i) { run += fcf[i]; e = fif[i] - run; pm = fmaxf(pm, e); }
    float mt = fmaxf(run + m_f, run + pm);
    bfv[tid] = run; ef[tid] = e; mtf[tid] = mt; af[tid] = __expf(run + m_f - mt);
  } else {
    int t = tid - 128;
    float run = 0.f, pm = -3.0e38f, e = 0.f;
#pragma unroll 8
    for (int i = 127; i >= t; --i) { run += fcb[i]; e = fib[i] - run; pm = fmaxf(pm, e); }
    float mt = fmaxf(run + m_b, run + pm);
    bbv[t] = run; eb[t] = e; mtb[t] = mt; ab[t] = __expf(run + m_b - mt);
  }
  float qn_f[2], qn_b[2];
#pragma unroll
  for (int mt = 0; mt < 2; ++mt) {
    float sf = 0.f, sb = 0.f;
#pragma unroll
    for (int ks = 0; ks < 4; ++ks) {
#pragma unroll
      for (int j = 0; j < 8; ++j) {
        float qv = bf2f((bf16_t)qa[mt][ks][j]);
        sf += qv * nf[ks * 32 + fq * 8 + j]; sb += qv * nb[ks * 32 + fq * 8 + j];
      }
      asm volatile("" ::: "memory");
    }
    sf += __shfl_xor(sf, 16); sf += __shfl_xor(sf, 32);
    sb += __shfl_xor(sb, 16); sb += __shfl_xor(sb, 32);
    qn_f[mt] = sf; qn_b[mt] = sb;
  }
  f32x4 sF[2][8];
#pragma unroll
  for (int mt = 0; mt < 2; ++mt)
#pragma unroll
    for (int nt = 0; nt < 8; ++nt) sF[mt][nt] = f32x4{0.f, 0.f, 0.f, 0.f};
  mma_regA(qa, B0, sF, fr, fq);
  __syncthreads();
  float cfv[2], cbv[2];
  {
    const int wid2 = __builtin_amdgcn_readfirstlane(wid) * 2;
    float xf[2], xb[2], rsF[2], rsB[2], dgF[2], dgB[2];
#pragma unroll
    for (int mt = 0; mt < 2; ++mt) {
      const int tau = wid * 32 + mt * 16 + fr;
      xf[mt] = bfv[tau] - mtf[tau]; xb[mt] = bbv[tau] - mtb[tau];
      rsF[mt] = 0.f; rsB[mt] = 0.f; dgF[mt] = 0.f; dgB[mt] = 0.f;
    }
#pragma unroll
    for (int nt = 0; nt < 8; ++nt) {
      const f32x4 e_f = *(const f32x4*)(ef + nt * 16 + fq * 4), e_b = *(const f32x4*)(eb + nt * 16 + fq * 4);
#pragma unroll
      for (int mt = 0; mt < 2; ++mt) {
        const int rel = nt - (wid2 + mt);
        if (rel < 0) {
#pragma unroll
          for (int r = 0; r < 4; ++r) { float v = sF[mt][nt][r] * __expf(xf[mt] + e_f[r]); rsF[mt] += v; sF[mt][nt][r] = v; }
        } else if (rel > 0) {
#pragma unroll
          for (int r = 0; r < 4; ++r) { float v = sF[mt][nt][r] * __expf(xb[mt] + e_b[r]); rsB[mt] += v; sF[mt][nt][r] = v; }
        } else {
#pragma unroll
          for (int r = 0; r < 4; ++r) {
            const int sg = fq * 4 + r;
            float s0 = sF[mt][nt][r];
            float vf = s0 * __expf(xf[mt] + e_f[r]), vb = s0 * __expf(xb[mt] + e_b[r]);
            if (sg < fr) { rsF[mt] += vf; sF[mt][nt][r] = vf; }
            else if (sg > fr) { rsB[mt] += vb; sF[mt][nt][r] = vb; }
            else { dgF[mt] = vf; dgB[mt] = vb; sF[mt][nt][r] = 0.f; }
          }
        }
      }
    }
    bf16_t* P = (bf16_t*)B0;
#pragma unroll
    for (int mt = 0; mt < 2; ++mt) {
      const int tau = wid * 32 + mt * 16 + fr;
      float a_ = rsF[mt] + dgF[mt], b_ = rsB[mt] + dgB[mt];
      a_ += __shfl_xor(a_, 16); a_ += __shfl_xor(a_, 32);
      b_ += __shfl_xor(b_, 16); b_ += __shfl_xor(b_, 32);
      const float denf = af[tau] * qn_f[mt] + a_, denb = ab[tau] * qn_b[mt] + b_;
      const float rf = frcp(fmaxf(fabsf(denf), __expf(-mtf[tau])));
      const float rb = frcp(fmaxf(fabsf(denb), __expf(-mtb[tau])));
      cfv[mt] = rf * af[tau]; cbv[mt] = rb * ab[tau];
      const float dg = rf * dgF[mt] + rb * dgB[mt];
#pragma unroll
      for (int nt = 0; nt < 8; ++nt) {
        const int rel = nt - (wid2 + mt);
        f32x4 pv;
#pragma unroll
        for (int r = 0; r < 4; ++r) {
          const int sg = fq * 4 + r;
          const float v = sF[mt][nt][r];
          pv[r] = rel < 0 ? rf * v : (rel > 0 ? rb * v : (sg < fr ? rf * v : (sg > fr ? rb * v : dg)));
        }
        *(uint2*)(P + tau * 136 + nt * 16 + fq * 4) = pack4(pv);
      }
      asm volatile("" ::: "memory");
    }
  }
  __syncthreads();
  f32x4 O[2][8];
#pragma unroll
  for (int mt = 0; mt < 2; ++mt)
#pragma unroll
    for (int nt = 0; nt < 8; ++nt) O[mt][nt] = f32x4{0.f, 0.f, 0.f, 0.f};
  {
    bf16x8 pa[2][4];
    load_fragA(pa, B0, wid * 32, fr, fq);
    mma_regA(pa, B1, O, fr, fq);
  }
  __syncthreads();
  {
    Tile8 tcf = tile_load(p.Cin + itf * 16384, 128, tid);
    Tile8 tcb = tile_load(p.Cin + itb * 16384, 128, tid);
    tile_put_R(B0, tcf, tid);
    tile_put_R(B1, tcb, tid);
  }
  __syncthreads();
  {
    bf16x8 qs[2][4];
#pragma unroll
    for (int ks = 0; ks < 4; ++ks) { qs[0][ks] = scale_frag(qa[0][ks], cfv[0]); qs[1][ks] = scale_frag(qa[1][ks], cfv[1]); }
    mma_regA(qs, B0, O, fr, fq);
#pragma unroll
    for (int ks = 0; ks < 4; ++ks) { qs[0][ks] = scale_frag(qa[0][ks], cbv[0]); qs[1][ks] = scale_frag(qa[1][ks], cbv[1]); }
    mma_regA(qs, B1, O, fr, fq);
  }
  const float* nw = p.mlstm_norm_w + l * 1024 + hh * 128;
#pragma unroll
  for (int mt = 0; mt < 2; ++mt) {
    const int tau = wid * 32 + mt * 16 + fr;
    float s = 0.f;
#pragma unroll
    for (int nt = 0; nt < 8; ++nt) s += O[mt][nt][0] + O[mt][nt][1] + O[mt][nt][2] + O[mt][nt][3];
    s += __shfl_xor(s, 16); s += __shfl_xor(s, 32);
    const float mu = s * (1.f / 128.f);
    float v = 0.f;
#pragma unroll
    for (int nt = 0; nt < 8; ++nt)
#pragma unroll
      for (int r = 0; r < 4; ++r) { float d = O[mt][nt][r] - mu; v += d * d; }
    v += __shfl_xor(v, 16); v += __shfl_xor(v, 32);
    const float rs = rsqrtf(v * (1.f / 128.f) + LN_EPS);
    const size_t tok = (size_t)(tok0 + tau);
#pragma unroll
    for (int nt = 0; nt < 8; ++nt) {
      const int vv = nt * 16 + fq * 4;
      const f32x4 og = sigmoid4(unpack4(*(const uint2*)(p.proj + tok * 8192 + 3072 + hh * 128 + vv)));
      const f32x4 nw4 = *(const f32x4*)(nw + vv);
      *(uint2*)(p.hA + tok * 1024 + hh * 128 + vv) = pack4(og * (O[mt][nt] - mu) * rs * nw4);
    }
    asm volatile("" ::: "memory");
  }
}

DEVI void phase_mout(const Params& p, int l, char* smem) {
  const int nG = (NT / 96) * 8;
  const float* bb = p.branch_b + l * 2048 + 1024;
  const int nb = gridDim.x, bid = BID();
  for (int item = bid; item < NITEM; item += nb) mout_item(p, l, item, smem);
  const int n_extra = NITEM % nb, n_light = nb - n_extra;
  if (bid >= n_extra) {
    for (int it = bid - n_extra; it < nG; it += n_light) {
      int mt = it % (NT / 96), nt = it / (NT / 96);
      const bf16_t* proj = p.proj; float* r = p.r;
      gemm96(p.hB, p.wt_pb, mt * 96, nt * 128, smem, [&](int m, int n, const f32x4& v) {
        f32x4 g = unpack4(*(const uint2*)(proj + (size_t)m * 8192 + 7168 + n)) + *(const f32x4*)(bb + n);
        *(f32x4*)(r + (size_t)m * 1024 + n) = sigmoid4(g) * v;
      });
    }
  }
}

DEVI void phase_g2a(const Params& p, int l, char* smem) {
  const int nM = NT / 96;
  const float* ba = p.branch_b + l * 2048;
  const bf16_t* proj = p.proj; const float* r = p.r; bf16_t* merged = p.merged;
  for (int it = 0;; ++it) {
    int mt, nt;
    if (!xcd_tile(it, nM, 8, mt, nt)) break;
    gemm96(p.hA, p.wt_pa, mt * 96, nt * 128, smem, [&](int m, int n, const f32x4& v) {
      f32x4 g = unpack4(*(const uint2*)(proj + (size_t)m * 8192 + 6144 + n)) + *(const f32x4*)(ba + n);
      *(uint2*)(merged + (size_t)m * 1024 + n) = pack4(sigmoid4(g) * v + *(const f32x4*)(r + (size_t)m * 1024 + n));
    });
  }
}

DEVI void phase_g3(const Params& p, int l, char* smem) {
  const int nM = NT / 96;
  const float* z = p.z; float* r = p.r; const float* mod = p.mod + (size_t)l * 3 * 6144;
  for (int it = 0;; ++it) {
    int mt, nt;
    if (!xcd_tile(it, nM, 8, mt, nt)) break;
    gemm96(p.merged, p.wt_out, mt * 96, nt * 128, smem, [&](int m, int n, const f32x4& v) {
      *(f32x4*)(r + (size_t)m * 1024 + n) = DN_ALPHA * *(const f32x4*)(z + (size_t)m * 1024 + n) + *(const f32x4*)(mod + mod_index(m) * 6144 + 2048 + n) * v;
    });
  }
}

DEVI void wave_ln(float (&v)[16], const float* w, const float* bsh, int lane) {
  float s = 0.f;
#pragma unroll
  for (int j = 0; j < 16; ++j) s += v[j];
  float mu = wave_sum(s) * (1.f / 1024.f);
  float q = 0.f;
#pragma unroll
  for (int j = 0; j < 16; ++j) { float d = v[j] - mu; q += d * d; }
  float rs = rsqrtf(wave_sum(q) * (1.f / 1024.f) + LN_EPS);
#pragma unroll
  for (int j = 0; j < 16; ++j) {
    int d = (j < 8 ? 0 : 512) + lane * 8 + (j & 7);
    v[j] = (v[j] - mu) * rs * w[d] + bsh[d];
  }
}
DEVI void load16(const float* src, int lane, float (&v)[16]) {
  float4 a = *(const float4*)(src + lane * 8), b = *(const float4*)(src + lane * 8 + 4);
  float4 c = *(const float4*)(src + 512 + lane * 8), d = *(const float4*)(src + 512 + lane * 8 + 4);
  v[0] = a.x; v[1] = a.y; v[2] = a.z; v[3] = a.w; v[4] = b.x; v[5] = b.y; v[6] = b.z; v[7] = b.w;
  v[8] = c.x; v[9] = c.y; v[10] = c.z; v[11] = c.w; v[12] = d.x; v[13] = d.y; v[14] = d.z; v[15] = d.w;
}
DEVI void store16(float* dst, int lane, const float (&v)[16]) {
  *(float4*)(dst + lane * 8) = float4{v[0], v[1], v[2], v[3]};
  *(float4*)(dst + lane * 8 + 4) = float4{v[4], v[5], v[6], v[7]};
  *(float4*)(dst + 512 + lane * 8) = float4{v[8], v[9], v[10], v[11]};
  *(float4*)(dst + 512 + lane * 8 + 4) = float4{v[12], v[13], v[14], v[15]};
}
DEVI void store16_mod_bf16(bf16_t* dst, int lane, const float (&v)[16], const float* shift, const float* scale) {
  float h[16];
#pragma unroll
  for (int j = 0; j < 16; ++j) {
    int d = (j < 8 ? 0 : 512) + lane * 8 + (j & 7);
    h[j] = v[j] * (1.f + scale[d]) + shift[d];
  }
  uint4 o0, o1;
  o0.x = pack2(h[0], h[1]); o0.y = pack2(h[2], h[3]); o0.z = pack2(h[4], h[5]); o0.w = pack2(h[6], h[7]);
  o1.x = pack2(h[8], h[9]); o1.y = pack2(h[10], h[11]); o1.z = pack2(h[12], h[13]); o1.w = pack2(h[14], h[15]);
  *(uint4*)(dst + lane * 8) = o0;
  *(uint4*)(dst + 512 + lane * 8) = o1;
}

DEVI void phase_ln1(const Params& p, int l) {
  const int lane = TID() & 63;
  const int gw = (BID() * 256 + TID()) >> 6, nw = gridDim.x * 4;
  for (int tok = gw; tok < NT; tok += nw) {
    float v[16];
    load16(p.r + (size_t)tok * 1024, lane, v);
    wave_ln(v, p.ln_w + (size_t)(l * 2 + 0) * 1024, p.ln_b + (size_t)(l * 2 + 0) * 1024, lane);
    store16(p.z + (size_t)tok * 1024, lane, v);
    const float* m = p.mod + ((size_t)l * 3 + mod_index(tok)) * 6144;
    store16_mod_bf16(p.h + (size_t)tok * 1024, lane, v, m + 3 * 1024, m + 4 * 1024);
  }
}

DEVI void phase_g4(const Params& p, int l, char* smem) {
  bf16_t* qry = p.qry;
  auto epi = [&](int m, int n, const f32x4& v) { *(uint2*)(qry + (size_t)m * 2048 + n) = pack4(v); };
  for (int it = 0;; ++it) {
    int mt, nt;
    if (!xcd_tile(it, 64, 16, mt, nt)) break;
    gemm256g(p.h, p.wt_q, mt * 256, nt * 128, smem, epi, qry, 2048, 2048);
  }
  for (int it = 0;; ++it) {
    int mt, nt;
    if (!xcd_tile(it, (NT - 16384) / 128, 16, mt, nt)) break;
    gemm128g(p.h, p.wt_q, 16384 + mt * 128, nt * 128, smem, epi);
  }
}

DEVI unsigned ord_enc(float f) { unsigned u = __float_as_uint(f); return (u & 0x80000000u) ? ~u : (u | 0x80000000u); }
DEVI float ord_dec(unsigned k) { unsigned u = (k & 0x80000000u) ? (k ^ 0x80000000u) : ~k; return __uint_as_float(u); }
DEVI unsigned umed3(unsigned a, unsigned b, unsigned c) { unsigned d; asm("v_med3_u32 %0, %1, %2, %3" : "=v"(d) : "v"(a), "v"(b), "v"(c)); return d; }
DEVI void ins16(unsigned (&r)[16], unsigned x) {
#pragma unroll
  for (int i = 15; i >= 1; --i) r[i] = umed3(r[i - 1], r[i], x);
  r[0] = max(r[0], x);
}

DEVI void merge16(unsigned (&r)[16], const unsigned (&o)[16]) {
#pragma unroll
  for (int i = 0; i < 16; ++i) r[i] = max(r[i], o[15 - i]);
#pragma unroll
  for (int st = 8; st >= 1; st >>= 1)
#pragma unroll
    for (int i = 0; i < 16; ++i)
      if ((i & st) == 0) { unsigned hi = max(r[i], r[i + st]), lo = min(r[i], r[i + st]); r[i] = hi; r[i + st] = lo; }
}
DEVI void phase_topk(const Params& p, int l, char* smem) {
  const int tid = TID(), lane = tid & 63, wid = tid >> 6, fr = lane & 15, fq = lane >> 4;
  const int hh = BID() & 7;
  __syncthreads();
  {
    const bf16_t* ksrc = p.keys + (size_t)(l & 1) * 262144 + (size_t)hh * 2 * 16384;
    Tile8 k0 = tile_load(ksrc, 128, tid);
    Tile8 k1 = tile_load(ksrc + 16384, 128, tid);
    tile_put_R(smem, k0, tid);
    tile_put_R(smem + 34816, k1, tid);
  }
  __syncthreads();
  unsigned* tab = (unsigned*)(smem + 69632) + (size_t)(wid * 16 + fr) * 33;
  const int ntg = NT / 16, tg_stride = (int)(gridDim.x >> 3) * 4;
  for (int tg = (BID() >> 3) * 4 + wid; tg < ntg; tg += tg_stride) {
    const int t0 = tg * 16;
    unsigned top[2][16];
#pragma unroll
    for (int ph = 0; ph < 2; ++ph) {
      const char* kb = smem + ph * 34816;
      const bf16_t* qb = p.qry + (size_t)(t0 + fr) * 2048 + hh * 256 + ph * 128;
      f32x4 acc[8];
#pragma unroll
      for (int mt = 0; mt < 8; ++mt) acc[mt] = f32x4{0.f, 0.f, 0.f, 0.f};
#pragma unroll
      for (int ks = 0; ks < 4; ++ks) {
        bf16x8 bq = *(const bf16x8*)(qb + ks * 32 + fq * 8);
#pragma unroll
        for (int mt = 0; mt < 8; ++mt) {
          bf16x8 ak = *(const bf16x8*)(kb + (mt * 16 + fr) * 272 + ks * 64 + fq * 16);
          acc[mt] = __builtin_amdgcn_mfma_f32_16x16x32_bf16(ak, bq, acc[mt], 0, 0, 0);
        }
      }
#pragma unroll
      for (int i = 0; i < 16; ++i) top[ph][i] = 0u;
#pragma unroll
      for (int mt = 0; mt < 8; ++mt)
#pragma unroll
        for (int r = 0; r < 4; ++r) {
          unsigned key = (ord_enc(acc[mt][r]) & ~0x7Fu) | (unsigned)(127 - (mt * 16 + fq * 4 + r));
          ins16(top[ph], key);
        }
#pragma unroll
      for (int st = 16; st <= 32; st <<= 1) {
        unsigned o[16];
#pragma unroll
        for (int i = 0; i < 16; ++i) o[i] = (unsigned)__shfl_xor((int)top[ph][i], st);
        merge16(top[ph], o);
      }
    }
    unsigned cd[16];
#pragma unroll
    for (int i = 0; i < 16; ++i) cd[i] = 0u;
    float v0[16], v1[16];
#pragma unroll
    for (int i = 0; i < 16; ++i) {
      v0[i] = ord_dec(top[0][i] & ~0x7Fu); v1[i] = ord_dec(top[1][i] & ~0x7Fu);
      tab[i] = 127u - (top[0][i] & 0x7Fu); tab[16 + i] = 127u - (top[1][i] & 0x7Fu);
    }
#pragma unroll
    for (int a = 0; a < 16; ++a)
#pragma unroll
      for (int bq = 0; bq < 16; ++bq)
        if ((a + 1) * (bq + 1) <= 16) {
          unsigned key = (ord_enc(v0[a] + v1[bq]) & ~0xFFu) | (unsigned)(255 - (a * 16 + bq));
          ins16(cd, key);
        }
    float sv[16];
    int ei[16];
    float mx = ord_dec(cd[0] & ~0xFFu), sum = 0.f;
#pragma unroll
    for (int i = 0; i < 16; ++i) {
      unsigned code = 255u - (cd[i] & 0xFFu);
      sv[i] = __expf(ord_dec(cd[i] & ~0xFFu) - mx);
      sum += sv[i];
      ei[i] = (int)(tab[code >> 4] * 128u + tab[16 + (code & 15u)]);
    }
    float inv = 1.f / sum;
    if (fq == 0) {
      int* di = p.eidx + (size_t)(t0 + fr) * 128 + hh * 16;
      float* dg = p.egate + (size_t)(t0 + fr) * 128 + hh * 16;
#pragma unroll
      for (int i = 0; i < 16; i += 4) {
        *(int4*)(di + i) = int4{ei[i], ei[i + 1], ei[i + 2], ei[i + 3]};
        *(float4*)(dg + i) = float4{sv[i] * inv, sv[i + 1] * inv, sv[i + 2] * inv, sv[i + 3] * inv};
      }
    }
  }
}

typedef float v2f_t __attribute__((ext_vector_type(2)));
DEVI float dot16_fp8(const uint4& a, const float (&x)[16]) {
  const unsigned w[4] = {a.x, a.y, a.z, a.w};
  float s0 = 0.f, s1 = 0.f;
#pragma unroll
  for (int i = 0; i < 4; ++i) {
    v2f_t lo = __builtin_amdgcn_cvt_pk_f32_fp8((int)w[i], false), hi = __builtin_amdgcn_cvt_pk_f32_fp8((int)w[i], true);
    s0 += lo[0] * x[4 * i]; s1 += lo[1] * x[4 * i + 1]; s0 += hi[0] * x[4 * i + 2]; s1 += hi[1] * x[4 * i + 3];
  }
  return s0 + s1;
}
DEVI void axpy16_fp8(float (&o)[16], float c, const uint4& a) {
  const unsigned w[4] = {a.x, a.y, a.z, a.w};
#pragma unroll
  for (int i = 0; i < 4; ++i) {
    v2f_t lo = __builtin_amdgcn_cvt_pk_f32_fp8((int)w[i], false), hi = __builtin_amdgcn_cvt_pk_f32_fp8((int)w[i], true);
    o[4 * i] += c * lo[0]; o[4 * i + 1] += c * lo[1]; o[4 * i + 2] += c * hi[0]; o[4 * i + 3] += c * hi[1];
  }
}
DEVI void load16c(const float* src, int lane, float (&v)[16]) {
#pragma unroll
  for (int i = 0; i < 4; ++i) {
    float4 a = *(const float4*)(src + lane * 16 + i * 4);
    v[4 * i] = a.x; v[4 * i + 1] = a.y; v[4 * i + 2] = a.z; v[4 * i + 3] = a.w;
  }
}
DEVI void store16c(float* dst, int lane, const float (&v)[16]) {
#pragma unroll
  for (int i = 0; i < 4; ++i) *(float4*)(dst + lane * 16 + i * 4) = float4{v[4 * i], v[4 * i + 1], v[4 * i + 2], v[4 * i + 3]};
}

DEVI void phase_gather(const Params& p, int l) {
  const int lane = TID() & 63;
  const int gw = (BID() * 256 + TID()) >> 6, nw = gridDim.x * 4;
  for (int tok = gw; tok < NT; tok += nw) {
    float x[16];
    {
      const bf16_t* hs = p.h + (size_t)tok * 1024 + lane * 16;
      uint4 a0 = *(const uint4*)(hs), a1 = *(const uint4*)(hs + 8);
      x[0] = lo2f(a0.x); x[1] = hi2f(a0.x); x[2] = lo2f(a0.y); x[3] = hi2f(a0.y); x[4] = lo2f(a0.z); x[5] = hi2f(a0.z); x[6] = lo2f(a0.w); x[7] = hi2f(a0.w);
      x[8] = lo2f(a1.x); x[9] = hi2f(a1.x); x[10] = lo2f(a1.y); x[11] = hi2f(a1.y); x[12] = lo2f(a1.z); x[13] = hi2f(a1.z); x[14] = lo2f(a1.w); x[15] = hi2f(a1.w);
    }
    float o[16];
#pragma unroll
    for (int j = 0; j < 16; ++j) o[j] = 0.f;
    const int* ei = p.eidx + (size_t)tok * 128;
    const float* eg = p.egate + (size_t)tok * 128;
    const int myi0 = ei[lane], myi1 = ei[64 + lane];
    const float* esc = p.escale + (l & 1) * 32768;
    const unsigned char* eub = p.eu + (size_t)(l & 1) * 16384 * 1024;
    const unsigned char* evb = p.ev + (size_t)(l & 1) * 16384 * 1024;
    const float mys0 = esc[myi0], mys1 = esc[myi1];
    const float myg0 = eg[lane] * esc[16384 + myi0], myg1 = eg[64 + lane] * esc[16384 + myi1];
#ifdef PROBE_GATHER
#pragma unroll 1
    for (int half4 = 0; half4 < 4; ++half4) {
      const int half = half4 & 1;
      const int myi = half ? myi1 : myi0; const float mys = half ? mys1 : mys0; const float myg = (half ? myg1 : myg0) * 0.5f;
#else
#pragma unroll 1
    for (int half = 0; half < 2; ++half) {
      const int myi = half ? myi1 : myi0; const float mys = half ? mys1 : mys0; const float myg = half ? myg1 : myg0;
#endif
#pragma unroll 1
      for (int e0 = 0; e0 < 64; e0 += 8) {
        uint4 u[8], v[8]; float gt[8], su[8];
#pragma unroll
        for (int j = 0; j < 8; ++j) {
          const int e = __builtin_amdgcn_readlane(myi, e0 + j);
          gt[j] = __builtin_bit_cast(float, __builtin_amdgcn_readlane(__builtin_bit_cast(int, myg), e0 + j));
          su[j] = __builtin_bit_cast(float, __builtin_amdgcn_readlane(__builtin_bit_cast(int, mys), e0 + j));
          u[j] = *(const uint4*)(eub + (size_t)e * 1024 + lane * 16);
          v[j] = *(const uint4*)(evb + (size_t)e * 1024 + lane * 16);
        }
        float d[8];
#pragma unroll
        for (int j = 0; j < 8; ++j) d[j] = dot16_fp8(u[j], x);
#pragma unroll
        for (int of = 32; of > 0; of >>= 1) {
#pragma unroll
          for (int j = 0; j < 8; ++j) d[j] += __shfl_xor(d[j], of);
        }
#pragma unroll
        for (int j = 0; j < 8; ++j) axpy16_fp8(o, gt[j] * gelu_f(su[j] * d[j]), v[j]);
      }
    }
    const float* m = p.mod + ((size_t)l * 3 + mod_index(tok)) * 6144;
    float zv[16];
    load16c(p.z + (size_t)tok * 1024, lane, zv);
    float s = 0.f;
#pragma unroll
    for (int j = 0; j < 16; ++j) { zv[j] = DN_ALPHA * zv[j] + m[5 * 1024 + lane * 16 + j] * o[j]; s += zv[j]; }
    const float mu = wave_sum(s) * (1.f / 1024.f);
    float q = 0.f;
#pragma unroll
    for (int j = 0; j < 16; ++j) { float dd = zv[j] - mu; q += dd * dd; }
    const float rs = rsqrtf(wave_sum(q) * (1.f / 1024.f) + LN_EPS);
    const float* lw = p.ln_w + (size_t)(l * 2 + 1) * 1024 + lane * 16;
    const float* lb = p.ln_b + (size_t)(l * 2 + 1) * 1024 + lane * 16;
#pragma unroll
    for (int j = 0; j < 16; ++j) zv[j] = (zv[j] - mu) * rs * lw[j] + lb[j];
    if (l == DEPTH - 1) {
      if (tok < NTX) store16c(p.out + (size_t)tok * 1024, lane, zv);
    } else {
      store16c(p.z + (size_t)tok * 1024, lane, zv);
      const float* m2 = p.mod + ((size_t)(l + 1) * 3 + mod_index(tok)) * 6144 + lane * 16;
      float hh[16];
#pragma unroll
      for (int j = 0; j < 16; ++j) hh[j] = zv[j] * (1.f + m2[1024 + j]) + m2[j];
      uint4 o0, o1;
      o0.x = pack2(hh[0], hh[1]); o0.y = pack2(hh[2], hh[3]); o0.z = pack2(hh[4], hh[5]); o0.w = pack2(hh[6], hh[7]);
      o1.x = pack2(hh[8], hh[9]); o1.y = pack2(hh[10], hh[11]); o1.z = pack2(hh[12], hh[13]); o1.w = pack2(hh[14], hh[15]);
      bf16_t* hd = p.h + (size_t)tok * 1024 + lane * 16;
      *(uint4*)hd = o0; *(uint4*)(hd + 8) = o1;
    }
  }
}

DEVI void run_phase(const Params& p, int ph, int l, char* smem) {
  if (ph == PH_PREP || ph == PH_TOPK) {
    const bool do_topk = ph == PH_TOPK;
    const bool do_prep = ph == PH_PREP || l < DEPTH - 1;
    const int lp = ph == PH_PREP ? l : l + 1;
    const bool prep_first = !do_topk || !((BID() >> 8) & 1);
#pragma unroll 1
    for (int step = 0; step < 2; ++step) {
      const bool prep_now = (step == 0) == prep_first;
      if (prep_now) { if (do_prep) phase_prep(p, lp, smem); }
      else { if (do_topk) phase_topk(p, l, smem); }
    }
    return;
  }
  switch (ph) {
    case PH_MOD: phase_mod(p, smem); break;
    case PH_PREP: break;
    case PH_G1: phase_g1(p, l, smem); break;
    case PH_CONV: phase_conv(p, l, smem); break;
    case PH_MLOC: phase_mloc(p, l, smem); break;
    case PH_SCAN: phase_scan(p); break;
    case PH_MOUT: phase_mout(p, l, smem); break;
    case PH_G2A: phase_g2a(p, l, smem); break;
    case PH_G3: phase_g3(p, l, smem); break;
    case PH_LN1: phase_ln1(p, l); break;
    case PH_G4: phase_g4(p, l, smem); break;
    case PH_TOPK: break;
    case PH_GATHER: phase_gather(p, l); break;
    default: break;
  }
}

__global__ void __launch_bounds__(256, 2) k_phase(Params p, int ph, int l) {
  extern __shared__ __attribute__((aligned(16))) char smem[];
  run_phase(p, ph, l, smem);
}

__global__ void __launch_bounds__(256, 2) k_mega(Params p) {
  extern __shared__ __attribute__((aligned(16))) char smem[];
  __shared__ uint4 xb_words;
  cg::grid_group grid = cg::this_grid();
  if (__builtin_amdgcn_workitem_id_x() == 0) xb_words = make_uint4(0u, 0u, 0u, 0u);
  __syncthreads();
  XcdBarrier xb = xcd_barrier_post(p.bar, (volatile LAS unsigned*)&xb_words);
  run_phase(p, PH_MOD, 0, smem);
  grid.sync();
  for (int l = 0; l < DEPTH; ++l) {
    for (int ph = (l == 0 ? PH_PREP : PH_G1); ph < PH_COUNT; ++ph) {
      run_phase(p, ph, l, smem);
#ifdef PROBE_PH
      if ((PROBE_PH >> ph) & 1) { xcd_barrier(xb); run_phase(p, ph, l, smem); }
#endif
      if (!(l == DEPTH - 1 && ph == PH_COUNT - 1)) xcd_barrier(xb);
    }
  }
}

extern "C" void kernel_launch(void* const* d_in, const int* in_sizes, int n_in, void* d_out, int out_size, void* d_ws,
                              size_t ws_size, hipStream_t stream) {
  Params p{};
  const float** pin = (const float**)&p;
  for (int i = 0; i < 24; ++i) pin[i] = (const float*)d_in[i];
  p.out = (float*)d_out;
  char* w = (char*)d_ws;
  size_t off = 0;
  auto take = [&](size_t bytes) { char* r = w + off; off += (bytes + 255) & ~(size_t)255; return r; };
  p.mod = (float*)take((size_t)4 * 3 * 6144 * 4);
  p.wt_in = (bf16_t*)take((size_t)INWP * 1024 * 2);
  p.wt_pa = (bf16_t*)take((size_t)1024 * 1024 * 2);
  p.wt_pb = (bf16_t*)take((size_t)1024 * 1024 * 2);
  p.wt_out = (bf16_t*)take((size_t)1024 * 1024 * 2);
  p.wt_q = (bf16_t*)take((size_t)2048 * 1024 * 2);
  p.keys = (bf16_t*)take((size_t)2 * 262144 * 2);
  p.eu = (unsigned char*)take((size_t)2 * 16384 * 1024);
  p.ev = (unsigned char*)take((size_t)2 * 16384 * 1024);
  p.escale = (float*)take((size_t)2 * 2 * 16384 * 4);
  p.z = (float*)take((size_t)NT * 1024 * 4);
  p.r = (float*)take((size_t)NT * 1024 * 4);
  p.h = (bf16_t*)take((size_t)NT * 1024 * 2);
  p.proj = (bf16_t*)take((size_t)NT * 8192 * 2);
  p.gates = (float*)take((size_t)NT * 32 * 4);
  p.q = (bf16_t*)take((size_t)NT * 1024 * 2);
  p.k = (bf16_t*)take((size_t)NT * 1024 * 2);
  p.sgu_stats = (float*)take((size_t)NT * 2 * 4);
  p.hA = (bf16_t*)take((size_t)NT * 1024 * 2);
  p.hB = (bf16_t*)take((size_t)NT * 1024 * 2);
  p.merged = (bf16_t*)take((size_t)NT * 1024 * 2);
  p.qry = p.proj;
  p.dC = (bf16_t*)take((size_t)2 * NITEM * 16384 * 2);
  p.Cin = (bf16_t*)take((size_t)2 * NITEM * 16384 * 2);
  p.dn = (float*)take((size_t)2 * NITEM * 128 * 4);
  p.nin = (float*)take((size_t)2 * NITEM * 128 * 4);
  p.cscal = (float*)take((size_t)2 * NITEM * 2 * 4);
  p.min_ = (float*)take((size_t)2 * NITEM * 4);
  p.eidx = (int*)take((size_t)NT * 128 * 4);
  p.egate = (float*)take((size_t)NT * 128 * 4);
  p.bar = (unsigned*)take((size_t)XCD_BAR_WORDS * 4);
  if (off > ws_size) { fprintf(stderr, "workspace too small: need %zu have %zu\n", off, ws_size); return; }

#if MEGA
  static int grid_blocks = 0;
  if (!grid_blocks) {
    (void)hipFuncSetAttribute((const void*)k_mega, hipFuncAttributeMaxDynamicSharedMemorySize, LDS_BYTES);
    int dev = 0, cus = 0, per_cu = 0;
    hipGetDevice(&dev);
    hipDeviceGetAttribute(&cus, hipDeviceAttributeMultiprocessorCount, dev);
    hipOccupancyMaxActiveBlocksPerMultiprocessor(&per_cu, k_mega, 256, LDS_BYTES);
    if (per_cu > 2) per_cu = 2;
    grid_blocks = cus * per_cu;
  }
  (void)hipMemsetAsync(p.bar, 0, (size_t)XCD_BAR_WORDS * 4, stream);
  void* args[] = {&p};
  hipError_t e = hipLaunchCooperativeKernel((void*)k_mega, dim3(grid_blocks), dim3(256), args, LDS_BYTES, stream);
  if (e != hipSuccess) fprintf(stderr, "cooperative launch failed: %s (grid %d)\n", hipGetErrorString(e), grid_blocks);
#else
  static bool attr = false;
  if (!attr) { (void)hipFuncSetAttribute((const void*)k_phase, hipFuncAttributeMaxDynamicSharedMemorySize, LDS_BYTES); attr = true; }
  const int grid = 512;
  k_phase<<<grid, 256, LDS_BYTES, stream>>>(p, PH_MOD, 0);
  for (int l = 0; l < DEPTH; ++l)
    for (int ph = PH_PREP; ph < PH_COUNT; ++ph) k_phase<<<grid, 256, LDS_BYTES, stream>>>(p, ph, l);
#endif
}
```

```cpp
#include <hip/hip_runtime.h>
#include <hip/hip_cooperative_groups.h>
#include <cstdio>
namespace cg = cooperative_groups;

#ifndef MEGA
#define MEGA 1
#endif

typedef unsigned short bf16_t;
using bf16x8 = __attribute__((ext_vector_type(8))) short;
using f32x4 = __attribute__((ext_vector_type(4))) float;
#define DEVI __device__ __forceinline__

constexpr int NTX = 16384, NTC = 512, NT = 16896, DEPTH = 4;
constexpr int INW = 8224, INWP = 8320;
constexpr int NITEM = 1056;
constexpr int LDS_BYTES = 79872;
constexpr int NBLK_THREADS = 256;
constexpr float DN_ALPHA = 1.681792830507429f;
constexpr float LN_EPS = 1e-5f;

enum { PH_MOD = 0, PH_PREP, PH_G1, PH_CONV, PH_MLOC, PH_SCAN, PH_MOUT, PH_G2A, PH_G3, PH_LN1, PH_G4, PH_TOPK, PH_GATHER, PH_COUNT };

struct Params {
  const float *x, *c, *ctx, *c_ctx, *w_mod, *b_mod, *w_in, *qk_conv_w, *qk_conv_b, *gate_b, *mlstm_norm_w,
      *sgu_norm_w, *sgu_w, *sgu_b, *branch_b, *p_a, *p_b, *w_out, *ln_w, *ln_b, *peer_wq, *peer_keys, *expert_u, *expert_v;
  float* out;
  float* mod;
  bf16_t* wt_in;
  bf16_t* wt_pa;
  bf16_t* wt_pb;
  bf16_t* wt_out;
  bf16_t* wt_q;
  bf16_t* keys;
  unsigned char* eu;
  unsigned char* ev;
  float* escale;
  float* z;
  float* r;
  bf16_t* h;
  bf16_t* proj;
  float* gates;
  bf16_t* q;
  bf16_t* k;
  float* sgu_stats;
  bf16_t* hA;
  bf16_t* hB;
  bf16_t* merged;
  bf16_t* qry;
  bf16_t* dC;
  bf16_t* Cin;
  float* dn;
  float* nin;
  float* cscal;
  float* min_;
  int* eidx;
  float* egate;
  unsigned* bar;
};

DEVI int TID() { int t = __builtin_amdgcn_workitem_id_x(); asm volatile("" : "+v"(t)); return t; }
DEVI int BID() { int b = __builtin_amdgcn_workgroup_id_x(); asm volatile("" : "+s"(b)); return b; }
DEVI float bf2f(bf16_t h) { return __uint_as_float(((unsigned)h) << 16); }
typedef __bf16 hwbf2_t __attribute__((ext_vector_type(2)));
typedef float hwf2_t __attribute__((ext_vector_type(2)));
DEVI unsigned pack2(float a, float b) { hwf2_t v = {a, b}; hwbf2_t r = __builtin_convertvector(v, hwbf2_t); return __builtin_bit_cast(unsigned, r); }
DEVI bf16_t f2bf(float f) { return (bf16_t)(pack2(f, f) & 0xFFFFu); }
DEVI float lo2f(unsigned u) { return __uint_as_float(u << 16); }
DEVI float hi2f(unsigned u) { return __uint_as_float(u & 0xFFFF0000u); }
DEVI float frcp(float x) { return __builtin_amdgcn_rcpf(x); }
DEVI float sigmoid_f(float x) { return frcp(1.f + __expf(-x)); }
DEVI float silu_f(float x) { return x * frcp(1.f + __expf(-x)); }
DEVI float gelu_f(float x) { float u = 0.7978845608028654f * (x + 0.044715f * x * x * x); return x * frcp(1.f + __expf(-2.f * u)); }
DEVI float logsigmoid_f(float x) { return fminf(x, 0.f) - log1pf(__expf(-fabsf(x))); }
DEVI uint2 pack4(const f32x4& v) { uint2 o; o.x = pack2(v[0], v[1]); o.y = pack2(v[2], v[3]); return o; }
DEVI f32x4 unpack4(uint2 u) { return f32x4{lo2f(u.x), hi2f(u.x), lo2f(u.y), hi2f(u.y)}; }
DEVI f32x4 sigmoid4(const f32x4& x) { return f32x4{sigmoid_f(x[0]), sigmoid_f(x[1]), sigmoid_f(x[2]), sigmoid_f(x[3])}; }
DEVI int mod_index(int tok) { return tok < 8192 ? 0 : (tok < 16384 ? 1 : 2); }
DEVI int tok_base(int b, int cidx) { return cidx < 64 ? b * 8192 + cidx * 128 : NTX + b * 256 + (cidx - 64) * 128; }
DEVI float wave_sum(float v) {
#pragma unroll
  for (int o = 32; o > 0; o >>= 1) v += __shfl_xor(v, o);
  return v;
}


#define XB_TMO      128
#define XB_XCNT(j)  (256  + 64 * (j))
#define XB_XSUB(j)  (1280 + 64 * (j))
#define XB_XGEN(j)  (2304 + 64 * (j))
#define XB_TOP      3328
#define XB_TOPGEN   3392
#define XCD_BAR_WORDS 3456
#define XB_SPIN_CAP (1u << 20)
#define LAS __attribute__((address_space(3)))
DEVI unsigned xb_ld(unsigned* p) { return __hip_atomic_load(p, __ATOMIC_RELAXED, __HIP_MEMORY_SCOPE_AGENT); }
DEVI unsigned xb_add(unsigned* p, unsigned v) { return __hip_atomic_fetch_add(p, v, __ATOMIC_RELAXED, __HIP_MEMORY_SCOPE_AGENT); }
DEVI unsigned xb_xcc_id() { return (unsigned)__builtin_amdgcn_s_getreg((3 << 11) | 20) & 0xFu; }
#define XB_SPIN(cond, bar) do { unsigned _sp = 0; while (cond) { __builtin_amdgcn_s_sleep(1); \
    if ((++_sp & 255u) == 0u) { if (xb_ld(&(bar)[XB_TMO])) break; if (_sp > XB_SPIN_CAP) { atomicAdd(&(bar)[XB_TMO], 1u); break; } } } } while (0)
struct XcdBarrier { unsigned* bar; unsigned x; volatile LAS unsigned* st; };
DEVI XcdBarrier xcd_barrier_post(unsigned* bar, volatile LAS unsigned* st) {
  XcdBarrier b; b.bar = bar; b.x = xb_xcc_id(); b.st = st;
  if (__builtin_amdgcn_workitem_id_x() == 0) (void)xb_add(&bar[XB_XCNT(b.x)], 1u);
  return b;
}
DEVI void xcd_barrier_complete(unsigned* bar, unsigned x, unsigned& nloc, unsigned& nx) {
  const unsigned G = gridDim.x * gridDim.y * gridDim.z;
  unsigned sum, cnt, mine, sp = 0u;
  for (;;) {
    sum = 0u; cnt = 0u; mine = 0u;
#pragma unroll
    for (unsigned j = 0; j < 16; ++j) { const unsigned c = xb_ld(&bar[XB_XCNT(j)]); sum += c; cnt += (c > 0u) ? 1u : 0u; mine = (j == x) ? c : mine; }
    if (sum == G) break;
    __builtin_amdgcn_s_sleep(1);
    if ((++sp & 255u) == 0u) { if (xb_ld(&bar[XB_TMO])) break; if (sp > XB_SPIN_CAP) { atomicAdd(&bar[XB_TMO], 1u); break; } }
  }
  nloc = mine > 0u ? mine : 1u; nx = cnt > 0u ? cnt : 1u;
}
DEVI void xcd_barrier(const XcdBarrier& b) {
  asm volatile("s_waitcnt vmcnt(0)" ::: "memory");
  __syncthreads();
  if (__builtin_amdgcn_workitem_id_x() == 0) {
    unsigned* bar = b.bar;
    __builtin_amdgcn_s_waitcnt(0);
    unsigned nloc = b.st[0], nx = b.st[1];
    if (nloc == 0u) { xcd_barrier_complete(bar, b.x, nloc, nx); b.st[0] = nloc; b.st[1] = nx; }
    const unsigned old = xb_add(&bar[XB_XSUB(b.x)], 1u);
    const unsigned gen = old / nloc;
    if (old + 1u == (gen + 1u) * nloc) {
      __builtin_amdgcn_fence(__ATOMIC_RELEASE, "agent");
      asm volatile("s_waitcnt vmcnt(0)" ::: "memory");
      const unsigned og = xb_add(&bar[XB_TOP], 1u);
      const unsigned tg = og / nx;
      if (og + 1u == (tg + 1u) * nx) xb_add(&bar[XB_TOPGEN], 1u);
      else XB_SPIN(xb_ld(&bar[XB_TOPGEN]) == tg, bar);
      __builtin_amdgcn_fence(__ATOMIC_ACQUIRE, "agent");
      xb_add(&bar[XB_XGEN(b.x)], 1u);
      asm volatile("s_waitcnt vmcnt(0)" ::: "memory");
    } else {
      XB_SPIN(xb_ld(&bar[XB_XGEN(b.x)]) == gen, bar);
      __builtin_amdgcn_fence(__ATOMIC_ACQUIRE, "agent");
      asm volatile("s_waitcnt vmcnt(0)" ::: "memory");
    }
  }
  __syncthreads();
}

template <int MI, class Epi>
DEVI void gemm_t(const bf16_t* __restrict__ A, const bf16_t* __restrict__ Bt, int m0, int n0, char* smem, Epi epi) {
  const int tid = TID(), lane = tid & 63, wid = tid >> 6, wr = wid >> 1, wc = wid & 1, fr = lane & 15, fq = lane >> 4;
  f32x4 acc[MI][4];
#pragma unroll
  for (int i = 0; i < MI; ++i)
#pragma unroll
    for (int j = 0; j < 4; ++j) acc[i][j] = f32x4{0.f, 0.f, 0.f, 0.f};
  const int srow = tid >> 3, scol = (tid & 7) * 8;
  const bf16_t* ga = A + (size_t)(m0 + srow) * 1024 + scol;
  const bf16_t* gb = Bt + (size_t)(n0 + srow) * 1024 + scol;
  uint4 pa0, pa1, pa2, pa3 = uint4{0, 0, 0, 0}, pb0, pb1, pb2, pb3, qa0, qa1, qa2, qa3 = uint4{0, 0, 0, 0}, qb0, qb1, qb2, qb3;
#define G_LOAD(P, KO) \
  P##a0 = *(const uint4*)(ga + (size_t)0 * 32 * 1024 + (KO)); P##a1 = *(const uint4*)(ga + (size_t)1 * 32 * 1024 + (KO)); \
  P##a2 = *(const uint4*)(ga + (size_t)2 * 32 * 1024 + (KO)); if (MI == 4) P##a3 = *(const uint4*)(ga + (size_t)3 * 32 * 1024 + (KO)); \
  P##b0 = *(const uint4*)(gb + (size_t)0 * 32 * 1024 + (KO)); P##b1 = *(const uint4*)(gb + (size_t)1 * 32 * 1024 + (KO)); \
  P##b2 = *(const uint4*)(gb + (size_t)2 * 32 * 1024 + (KO)); P##b3 = *(const uint4*)(gb + (size_t)3 * 32 * 1024 + (KO));
#define G_STORE(P, BASE) \
  *(uint4*)((BASE) + swoff + 0 * 32 * 144) = P##a0; *(uint4*)((BASE) + swoff + 1 * 32 * 144) = P##a1; \
  *(uint4*)((BASE) + swoff + 2 * 32 * 144) = P##a2; if (MI == 4) *(uint4*)((BASE) + swoff + 3 * 32 * 144) = P##a3; \
  *(uint4*)((BASE) + 18432 + swoff + 0 * 32 * 144) = P##b0; *(uint4*)((BASE) + 18432 + swoff + 1 * 32 * 144) = P##b1; \
  *(uint4*)((BASE) + 18432 + swoff + 2 * 32 * 144) = P##b2; *(uint4*)((BASE) + 18432 + swoff + 3 * 32 * 144) = P##b3;
#define G_COMPUTE(BASE) \
  _Pragma("unroll") for (int ks = 0; ks < 2; ++ks) { \
    bf16x8 a[MI], b[4]; \
    _Pragma("unroll") for (int i = 0; i < MI; ++i) a[i] = *(const bf16x8*)((BASE) + (wr * (MI * 16) + i * 16 + fr) * 144 + ks * 64 + fq * 16); \
    _Pragma("unroll") for (int j = 0; j < 4; ++j) b[j] = *(const bf16x8*)((BASE) + 18432 + (wc * 64 + j * 16 + fr) * 144 + ks * 64 + fq * 16); \
    __builtin_amdgcn_s_setprio(1); \
    _Pragma("unroll") for (int i = 0; i < MI; ++i) \
      _Pragma("unroll") for (int j = 0; j < 4; ++j) acc[i][j] = __builtin_amdgcn_mfma_f32_16x16x32_bf16(b[j], a[i], acc[i][j], 0, 0, 0); \
    __builtin_amdgcn_s_setprio(0); \
  }
  G_LOAD(p, 0)
  const int swoff = srow * 144 + scol * 2;
  __syncthreads();
  G_STORE(p, smem)
  G_LOAD(p, 64)
  __syncthreads();
  for (int kt = 0; kt < 16; kt += 2) {
    const int k2 = (kt + 2 < 16 ? kt + 2 : 15) * 64, k3 = (kt + 3 < 16 ? kt + 3 : 15) * 64;
    G_LOAD(q, k2)
    __builtin_amdgcn_sched_barrier(0);
    G_COMPUTE(smem)
    __builtin_amdgcn_sched_barrier(0);
    G_STORE(p, smem + 36864)
    __syncthreads();
    G_LOAD(p, k3)
    __builtin_amdgcn_sched_barrier(0);
    G_COMPUTE(smem + 36864)
    __builtin_amdgcn_sched_barrier(0);
    G_STORE(q, smem)
    __syncthreads();
  }
#undef G_LOAD
#undef G_STORE
#undef G_COMPUTE
#pragma unroll
  for (int i = 0; i < MI; ++i)
#pragma unroll
    for (int j = 0; j < 4; ++j) epi(m0 + wr * (MI * 16) + i * 16 + fr, n0 + wc * 64 + j * 16 + fq * 4, acc[i][j]);
}

#define LDS3 __attribute__((address_space(3)))
template <class Epi>
DEVI void gemm128g(const bf16_t* __restrict__ A, const bf16_t* __restrict__ Bt, int m0, int n0, char* smem, Epi epi) {
  const int tid = TID(), lane = tid & 63, wid = __builtin_amdgcn_readfirstlane(tid >> 6), wr = wid >> 1, wc = wid & 1, fr = lane & 15, fq = lane >> 4;
  f32x4 acc[4][4];
#pragma unroll
  for (int i = 0; i < 4; ++i)
#pragma unroll
    for (int j = 0; j < 4; ++j) acc[i][j] = f32x4{0.f, 0.f, 0.f, 0.f};
  const int rr = lane >> 2, cchunk = (lane & 3) ^ ((0x78 >> (2 * ((rr >> 2) & 3))) & 3);
  const bf16_t* gA0 = A + (size_t)(m0 + wid * 32 + rr) * 1024 + cchunk * 8;
  const bf16_t* gB0 = Bt + (size_t)(n0 + wid * 32 + rr) * 1024 + cchunk * 8;
  const int segA = wid * 2048, segB = 8192 + wid * 2048;
#define GL_ISSUE(KT) { const int s_ = ((KT) & 3) * 16384; const int ko_ = ((KT) < 31 ? (KT) : 31) * 32; \
    __builtin_amdgcn_global_load_lds((const unsigned*)(gA0 + ko_), (LDS3 unsigned*)(smem + s_ + segA), 16, 0, 0); \
    __builtin_amdgcn_global_load_lds((const unsigned*)(gA0 + ko_ + 16 * 1024), (LDS3 unsigned*)(smem + s_ + segA + 1024), 16, 0, 0); \
    __builtin_amdgcn_global_load_lds((const unsigned*)(gB0 + ko_), (LDS3 unsigned*)(smem + s_ + segB), 16, 0, 0); \
    __builtin_amdgcn_global_load_lds((const unsigned*)(gB0 + ko_ + 16 * 1024), (LDS3 unsigned*)(smem + s_ + segB + 1024), 16, 0, 0); }
  const int swz = (0x78 >> (2 * ((fr >> 2) & 3))) & 3;
  const int rdA = (wr * 64 + fr) * 64 + ((fq ^ swz) * 16);
  const int rdB = 8192 + (wc * 64 + fr) * 64 + ((fq ^ swz) * 16);
  __syncthreads();
  GL_ISSUE(0) GL_ISSUE(1) GL_ISSUE(2)
#pragma unroll 1
  for (int kt = 0; kt < 32; ++kt) {
    asm volatile("s_waitcnt vmcnt(8)" ::: "memory");
    __builtin_amdgcn_s_barrier();
    GL_ISSUE(kt + 3)
    const char* st = smem + (kt & 3) * 16384;
    bf16x8 a[4], b[4];
#pragma unroll
    for (int i = 0; i < 4; ++i) a[i] = *(const bf16x8*)(st + rdA + i * 1024);
#pragma unroll
    for (int j = 0; j < 4; ++j) b[j] = *(const bf16x8*)(st + rdB + j * 1024);
    __builtin_amdgcn_s_setprio(1);
#pragma unroll
    for (int i = 0; i < 4; ++i)
#pragma unroll
      for (int j = 0; j < 4; ++j) acc[i][j] = __builtin_amdgcn_mfma_f32_16x16x32_bf16(b[j], a[i], acc[i][j], 0, 0, 0);
    __builtin_amdgcn_s_setprio(0);
  }
  asm volatile("s_waitcnt vmcnt(0)" ::: "memory");
  __syncthreads();
#undef GL_ISSUE
#pragma unroll
  for (int i = 0; i < 4; ++i)
#pragma unroll
    for (int j = 0; j < 4; ++j) epi(m0 + wr * 64 + i * 16 + fr, n0 + wc * 64 + j * 16 + fq * 4, acc[i][j]);
}

template <class Epi>
DEVI void gemm256g(const bf16_t* __restrict__ A, const bf16_t* __restrict__ Bt, int m0, int n0, char* smem, Epi epi,
                    bf16_t* __restrict__ sout = nullptr, int ldo = 0, int n_staged = 0) {
  const int tid = TID(), lane = tid & 63, wid = __builtin_amdgcn_readfirstlane(tid >> 6), wr = wid >> 1, wc = wid & 1, fr = lane & 15, fq = lane >> 4;
  f32x4 acc[8][4];
#pragma unroll
  for (int i = 0; i < 8; ++i)
#pragma unroll
    for (int j = 0; j < 4; ++j) acc[i][j] = f32x4{0.f, 0.f, 0.f, 0.f};
  const int rr = lane >> 2, cchunk = (lane & 3) ^ ((0x78 >> (2 * ((rr >> 2) & 3))) & 3);
  const bf16_t* gA0 = A + (size_t)(m0 + wid * 64 + rr) * 1024 + cchunk * 8;
  const bf16_t* gB0 = Bt + (size_t)(n0 + wid * 32 + rr) * 1024 + cchunk * 8;
  const int segA = wid * 4096, segB = 16384 + wid * 2048;
#define GL2_ISSUE(KT, ST) { const int s_ = (ST) * 24576; const int ko_ = ((KT) < 31 ? (KT) : 31) * 32; \
    __builtin_amdgcn_global_load_lds((const unsigned*)(gA0 + ko_), (LDS3 unsigned*)(smem + s_ + segA), 16, 0, 0); \
    __builtin_amdgcn_global_load_lds((const unsigned*)(gA0 + ko_ + 16 * 1024), (LDS3 unsigned*)(smem + s_ + segA + 1024), 16, 0, 0); \
    __builtin_amdgcn_global_load_lds((const unsigned*)(gA0 + ko_ + 32 * 1024), (LDS3 unsigned*)(smem + s_ + segA + 2048), 16, 0, 0); \
    __builtin_amdgcn_global_load_lds((const unsigned*)(gA0 + ko_ + 48 * 1024), (LDS3 unsigned*)(smem + s_ + segA + 3072), 16, 0, 0); \
    __builtin_amdgcn_global_load_lds((const unsigned*)(gB0 + ko_), (LDS3 unsigned*)(smem + s_ + segB), 16, 0, 0); \
    __builtin_amdgcn_global_load_lds((const unsigned*)(gB0 + ko_ + 16 * 1024), (LDS3 unsigned*)(smem + s_ + segB + 1024), 16, 0, 0); }
  const int swz = (0x78 >> (2 * ((fr >> 2) & 3))) & 3;
  const int rdA = (wr * 128 + fr) * 64 + ((fq ^ swz) * 16);
  const int rdB = 16384 + (wc * 64 + fr) * 64 + ((fq ^ swz) * 16);
  __syncthreads();
  GL2_ISSUE(0, 0) GL2_ISSUE(1, 1)
  int stc = 0;
#pragma unroll 1
  for (int kt = 0; kt < 32; ++kt) {
    asm volatile("s_waitcnt vmcnt(6)" ::: "memory");
    __builtin_amdgcn_s_barrier();
    { const int stn = stc == 0 ? 2 : stc - 1; GL2_ISSUE(kt + 2, stn) }
    const char* st = smem + stc * 24576;
    bf16x8 b[4];
#pragma unroll
    for (int j = 0; j < 4; ++j) b[j] = *(const bf16x8*)(st + rdB + j * 1024);
    __builtin_amdgcn_s_setprio(1);
#pragma unroll
    for (int i = 0; i < 8; ++i) {
      bf16x8 a = *(const bf16x8*)(st + rdA + i * 1024);
#pragma unroll
      for (int j = 0; j < 4; ++j) acc[i][j] = __builtin_amdgcn_mfma_f32_16x16x32_bf16(b[j], a, acc[i][j], 0, 0, 0);
    }
    __builtin_amdgcn_s_setprio(0);
    stc = stc == 2 ? 0 : stc + 1;
  }
  asm volatile("s_waitcnt vmcnt(0)" ::: "memory");
  __syncthreads();
#undef GL2_ISSUE
  if (sout != nullptr && n0 < n_staged) {
#pragma unroll
    for (int i = 0; i < 8; ++i)
#pragma unroll
      for (int j = 0; j < 4; ++j) *(uint2*)(smem + (wr * 128 + i * 16 + fr) * 272 + (wc * 64 + j * 16 + fq * 4) * 2) = pack4(acc[i][j]);
    __syncthreads();
#pragma unroll 4
    for (int it = 0; it < 16; ++it) {
      const int c = tid + it * 256, row = c >> 4, c16 = c & 15;
      *(uint4*)(sout + (size_t)(m0 + row) * ldo + n0 + c16 * 8) = *(const uint4*)(smem + row * 272 + c16 * 16);
    }
    return;
  }
#pragma unroll
  for (int i = 0; i < 8; ++i)
#pragma unroll
    for (int j = 0; j < 4; ++j) epi(m0 + wr * 128 + i * 16 + fr, n0 + wc * 64 + j * 16 + fq * 4, acc[i][j]);
}

template <class Epi>
DEVI void gemm128(const bf16_t* __restrict__ A, const bf16_t* __restrict__ Bt, int m0, int n0, char* smem, Epi epi) { gemm_t<4>(A, Bt, m0, n0, smem, epi); }
template <class Epi>
DEVI void gemm96(const bf16_t* __restrict__ A, const bf16_t* __restrict__ Bt, int m0, int n0, char* smem, Epi epi) { gemm_t<3>(A, Bt, m0, n0, smem, epi); }

DEVI void transpose_tile(const float* __restrict__ src, int N, int k0, int n0, bf16_t* __restrict__ dst, int dstrow0, char* smem) {
  float* t = (float*)smem;
  const int tid = TID();
  __syncthreads();
#pragma unroll
  for (int i = 0; i < 8; ++i) {
    int kk = (tid >> 5) + i * 8, nn = tid & 31;
    t[kk * 33 + nn] = src[(size_t)(k0 + kk) * N + n0 + nn];
  }
  __syncthreads();
  int nn = tid >> 3, ks = (tid & 7) * 8;
  float v[8];
#pragma unroll
  for (int j = 0; j < 8; ++j) v[j] = t[(ks + j) * 33 + nn];
  uint4 o;
  o.x = pack2(v[0], v[1]); o.y = pack2(v[2], v[3]); o.z = pack2(v[4], v[5]); o.w = pack2(v[6], v[7]);
  *(uint4*)(dst + (size_t)(dstrow0 + nn) * 1024 + k0 + ks) = o;
}

struct Tile8 { uint4 v0, v1, v2, v3, v4, v5, v6, v7; };
DEVI Tile8 tile_load(const bf16_t* __restrict__ src, int ld, int tid) {
  Tile8 t;
  const bf16_t* s0 = src + (size_t)(tid >> 4) * ld + (tid & 15) * 8;
  t.v0 = *(const uint4*)(s0); t.v1 = *(const uint4*)(s0 + (size_t)16 * ld); t.v2 = *(const uint4*)(s0 + (size_t)32 * ld); t.v3 = *(const uint4*)(s0 + (size_t)48 * ld);
  t.v4 = *(const uint4*)(s0 + (size_t)64 * ld); t.v5 = *(const uint4*)(s0 + (size_t)80 * ld); t.v6 = *(const uint4*)(s0 + (size_t)96 * ld); t.v7 = *(const uint4*)(s0 + (size_t)112 * ld);
  return t;
}
DEVI void tile_put_T1(bf16_t* dst, const uint4& u, int row, int c8, const float* scale) {
  unsigned w[4] = {u.x, u.y, u.z, u.w};
  if (scale) {
    float s = scale[row];
#pragma unroll
    for (int j = 0; j < 4; ++j) {
      dst[(c8 + 2 * j) * 136 + row] = f2bf(lo2f(w[j]) * s);
      dst[(c8 + 2 * j + 1) * 136 + row] = f2bf(hi2f(w[j]) * s);
    }
  } else {
#pragma unroll
    for (int j = 0; j < 4; ++j) {
      dst[(c8 + 2 * j) * 136 + row] = (bf16_t)(w[j] & 0xFFFF);
      dst[(c8 + 2 * j + 1) * 136 + row] = (bf16_t)(w[j] >> 16);
    }
  }
}
DEVI void tile_put_T(char* dstb, const Tile8& t, int tid, const float* scale) {
  bf16_t* dst = (bf16_t*)dstb;
  const int row = tid >> 4, c8 = (tid & 15) * 8;
  tile_put_T1(dst, t.v0, row, c8, scale); tile_put_T1(dst, t.v1, row + 16, c8, scale); tile_put_T1(dst, t.v2, row + 32, c8, scale); tile_put_T1(dst, t.v3, row + 48, c8, scale);
  tile_put_T1(dst, t.v4, row + 64, c8, scale); tile_put_T1(dst, t.v5, row + 80, c8, scale); tile_put_T1(dst, t.v6, row + 96, c8, scale); tile_put_T1(dst, t.v7, row + 112, c8, scale);
}
struct TileT { uint4 a0, a1, a2, a3, b0, b1, b2, b3; };
DEVI TileT tile_loadT(const bf16_t* __restrict__ src, int ld, int tid) {
  TileT t;
  const bf16_t* s0 = src + (size_t)((tid & 63) * 2) * ld + (tid >> 6) * 32;
  const bf16_t* s1 = s0 + ld;
  t.a0 = *(const uint4*)(s0); t.a1 = *(const uint4*)(s0 + 8); t.a2 = *(const uint4*)(s0 + 16); t.a3 = *(const uint4*)(s0 + 24);
  t.b0 = *(const uint4*)(s1); t.b1 = *(const uint4*)(s1 + 8); t.b2 = *(const uint4*)(s1 + 16); t.b3 = *(const uint4*)(s1 + 24);
  return t;
}
DEVI void tile_putT_chunk(unsigned* dst, const uint4& ua, const uint4& ub, int cbase, int rp, bool scaled, float sa, float sb) {
  const unsigned wa[4] = {ua.x, ua.y, ua.z, ua.w}, wb[4] = {ub.x, ub.y, ub.z, ub.w};
#pragma unroll
  for (int k = 0; k < 4; ++k) {
    unsigned lo, hi;
    if (scaled) { lo = pack2(lo2f(wa[k]) * sa, lo2f(wb[k]) * sb); hi = pack2(hi2f(wa[k]) * sa, hi2f(wb[k]) * sb); }
    else { lo = (wa[k] & 0xFFFFu) | (wb[k] << 16); hi = (wa[k] >> 16) | (wb[k] & 0xFFFF0000u); }
    dst[(cbase + 2 * k) * 68 + rp] = lo;
    dst[(cbase + 2 * k + 1) * 68 + rp] = hi;
  }
}
DEVI void tile_putT2(char* dstb, const TileT& t, int tid, const float* scale) {
  unsigned* dst = (unsigned*)dstb;
  const int rp = tid & 63, c0 = (tid >> 6) * 32;
  const bool scaled = scale != nullptr;
  float sa = 1.f, sb = 1.f;
  if (scaled) { sa = scale[2 * rp]; sb = scale[2 * rp + 1]; }
  tile_putT_chunk(dst, t.a0, t.b0, c0, rp, scaled, sa, sb);
  tile_putT_chunk(dst, t.a1, t.b1, c0 + 8, rp, scaled, sa, sb);
  tile_putT_chunk(dst, t.a2, t.b2, c0 + 16, rp, scaled, sa, sb);
  tile_putT_chunk(dst, t.a3, t.b3, c0 + 24, rp, scaled, sa, sb);
}
DEVI void tile_put_R(char* dstb, const Tile8& t, int tid) {
  char* d = dstb + (tid >> 4) * 272 + (tid & 15) * 16;
  *(uint4*)(d) = t.v0; *(uint4*)(d + 16 * 272) = t.v1; *(uint4*)(d + 32 * 272) = t.v2; *(uint4*)(d + 48 * 272) = t.v3;
  *(uint4*)(d + 64 * 272) = t.v4; *(uint4*)(d + 80 * 272) = t.v5; *(uint4*)(d + 96 * 272) = t.v6; *(uint4*)(d + 112 * 272) = t.v7;
}
DEVI void stage_T(char* dstb, const bf16_t* __restrict__ src, int ld, const float* scale) {
  const int tid = TID();
  Tile8 t = tile_load(src, ld, tid);
  tile_put_T(dstb, t, tid, scale);
}
DEVI void stage_R(char* dstb, const bf16_t* __restrict__ src, int ld) {
  const int tid = TID();
  Tile8 t = tile_load(src, ld, tid);
  tile_put_R(dstb, t, tid);
}

DEVI void mma_regA(const bf16x8 (&a)[2][4], const char* B, f32x4 (&acc)[2][8], int fr, int fq) {
#pragma unroll
  for (int ks = 0; ks < 4; ++ks) {
    bf16x8 bfr[8];
#pragma unroll
    for (int nt = 0; nt < 8; ++nt) bfr[nt] = *(const bf16x8*)(B + (nt * 16 + fr) * 272 + ks * 64 + fq * 16);
    __builtin_amdgcn_s_setprio(1);
#pragma unroll
    for (int nt = 0; nt < 8; ++nt) {
      bf16x8 b = bfr[nt];
#pragma unroll
      for (int mt = 0; mt < 2; ++mt) acc[mt][nt] = __builtin_amdgcn_mfma_f32_16x16x32_bf16(b, a[mt][ks], acc[mt][nt], 0, 0, 0);
    }
    __builtin_amdgcn_s_setprio(0);
    asm volatile("" ::: "memory");
  }
}
DEVI void load_fragA(bf16x8 (&a)[2][4], const char* A, int rowbase, int fr, int fq) {
#pragma unroll
  for (int mt = 0; mt < 2; ++mt)
#pragma unroll
    for (int ks = 0; ks < 4; ++ks) a[mt][ks] = *(const bf16x8*)(A + (rowbase + mt * 16 + fr) * 272 + ks * 64 + fq * 16);
}

DEVI void phase_mod(const Params& p, char* smem) {
  float* s = (float*)smem;
  float* red = s + 3072;
  const int tid = TID();
  for (int i = tid; i < 1024; i += 256) {
    s[i] = silu_f(p.c[i]);
    s[1024 + i] = silu_f(p.c[1024 + i]);
    s[2048 + i] = silu_f(p.c_ctx[i]);
  }
  __syncthreads();
  const int kg = tid >> 6, col = tid & 63;
  for (int item = BID(); item < 4 * 96; item += gridDim.x) {
    int l = item / 96, cb = item % 96, n = cb * 64 + col;
    const float* W = p.w_mod + (size_t)l * 1024 * 6144 + n;
    float a0 = 0, a1 = 0, a2 = 0;
#pragma unroll 32
    for (int k = kg * 256; k < kg * 256 + 256; ++k) {
      float w = W[(size_t)k * 6144];
      a0 += s[k] * w; a1 += s[1024 + k] * w; a2 += s[2048 + k] * w;
    }
    red[(kg * 3 + 0) * 64 + col] = a0; red[(kg * 3 + 1) * 64 + col] = a1; red[(kg * 3 + 2) * 64 + col] = a2;
    __syncthreads();
    if (tid < 192) {
      int i = tid >> 6;
      float v = red[(0 * 3 + i) * 64 + col] + red[(1 * 3 + i) * 64 + col] + red[(2 * 3 + i) * 64 + col] + red[(3 * 3 + i) * 64 + col];
      p.mod[((size_t)l * 3 + i) * 6144 + n] = v + p.b_mod[l * 6144 + n];
    }
    __syncthreads();
  }
}

DEVI void phase_prep(const Params& p, int l, char* smem) {
  const int tid = TID();
  const int n_in = 257 * 16, n_sq = 32 * 16, n_q = 64 * 16;
  const int total = n_in + 3 * n_sq + n_q;
  for (int item = BID(); item < total; item += gridDim.x) {
    int it = item;
    if (it < n_in) {
      int nt = it >> 4, kt = it & 15, n0 = nt * 32;
      int d0 = n0 < 4096 ? n0 : (n0 < 4128 ? n0 + 4096 : n0 - 32);
      transpose_tile(p.w_in + (size_t)l * 1024 * INW, INW, kt * 64, n0, p.wt_in, d0, smem);
    } else if ((it -= n_in) < 3 * n_sq) {
      int which = it / n_sq; it %= n_sq;
      int nt = it >> 4, kt = it & 15;
      const float* src = (which == 0 ? p.p_a : which == 1 ? p.p_b : p.w_out) + (size_t)l * 1024 * 1024;
      bf16_t* dst = which == 0 ? p.wt_pa : which == 1 ? p.wt_pb : p.wt_out;
      transpose_tile(src, 1024, kt * 64, nt * 32, dst, nt * 32, smem);
    } else {
      it -= 3 * n_sq;
      int nt = it >> 4, kt = it & 15;
      transpose_tile(p.peer_wq + (size_t)l * 1024 * 2048, 2048, kt * 64, nt * 32, p.wt_q, nt * 32, smem);
    }
  }
  const size_t gtid = (size_t)BID() * 256 + tid, gstride = (size_t)gridDim.x * 256;
  for (size_t i = gtid; i < (size_t)(INWP - INW) * 1024 / 8; i += gstride) ((uint4*)(p.wt_in + (size_t)INW * 1024))[i] = uint4{0, 0, 0, 0};
  {
    const int lane = tid & 63;
    const int gw = (int)(gtid >> 6), nw = (int)(gstride >> 6);
    for (int row = gw; row < 32768; row += nw) {
      const int e = row & 16383, which = row >> 14;
      const float* src = (which ? p.expert_v : p.expert_u) + ((size_t)l * 16384 + e) * 1024 + lane * 16;
      float4 a0 = *(const float4*)(src), a1 = *(const float4*)(src + 4), a2 = *(const float4*)(src + 8), a3 = *(const float4*)(src + 12);
      float am = fmaxf(fmaxf(fmaxf(fabsf(a0.x), fabsf(a0.y)), fmaxf(fabsf(a0.z), fabsf(a0.w))), fmaxf(fmaxf(fabsf(a1.x), fabsf(a1.y)), fmaxf(fabsf(a1.z), fabsf(a1.w))));
      am = fmaxf(am, fmaxf(fmaxf(fmaxf(fabsf(a2.x), fabsf(a2.y)), fmaxf(fabsf(a2.z), fabsf(a2.w))), fmaxf(fmaxf(fabsf(a3.x), fabsf(a3.y)), fmaxf(fabsf(a3.z), fabsf(a3.w)))));
#pragma unroll
      for (int o = 32; o > 0; o >>= 1) am = fmaxf(am, __shfl_xor(am, o));
      const float sc = am > 0.f ? am * (1.f / 440.f) : 1.f, inv = 1.f / sc;
      int w0 = 0, w1 = 0, w2 = 0, w3 = 0;
      w0 = __builtin_amdgcn_cvt_pk_fp8_f32(a0.x * inv, a0.y * inv, w0, false); w0 = __builtin_amdgcn_cvt_pk_fp8_f32(a0.z * inv, a0.w * inv, w0, true);
      w1 = __builtin_amdgcn_cvt_pk_fp8_f32(a1.x * inv, a1.y * inv, w1, false); w1 = __builtin_amdgcn_cvt_pk_fp8_f32(a1.z * inv, a1.w * inv, w1, true);
      w2 = __builtin_amdgcn_cvt_pk_fp8_f32(a2.x * inv, a2.y * inv, w2, false); w2 = __builtin_amdgcn_cvt_pk_fp8_f32(a2.z * inv, a2.w * inv, w2, true);
      w3 = __builtin_amdgcn_cvt_pk_fp8_f32(a3.x * inv, a3.y * inv, w3, false); w3 = __builtin_amdgcn_cvt_pk_fp8_f32(a3.z * inv, a3.w * inv, w3, true);
      unsigned char* dst = (which ? p.ev : p.eu) + (size_t)(l & 1) * 16384 * 1024 + (size_t)e * 1024 + lane * 16;
      *(uint4*)dst = uint4{(unsigned)w0, (unsigned)w1, (unsigned)w2, (unsigned)w3};
      if (lane == 0) p.escale[(l & 1) * 32768 + which * 16384 + e] = sc;
    }
  }
  {
    const float* sk = p.peer_keys + (size_t)l * 262144;
    for (size_t i = gtid; i < 262144; i += gstride) p.keys[(size_t)(l & 1) * 262144 + i] = f2bf(sk[i]);
  }
  if (l == 0) {
    for (size_t i = gtid; i < (size_t)NT * 256; i += gstride) {
      int tok = (int)(i >> 8), d = (int)(i & 255) * 4;
      float4 v = tok < NTX ? *(const float4*)(p.x + (size_t)tok * 1024 + d) : *(const float4*)(p.ctx + (size_t)(tok - NTX) * 1024 + d);
      *(float4*)(p.z + (size_t)tok * 1024 + d) = v;
      const float* m = p.mod + (size_t)mod_index(tok) * 6144;
      float h0 = v.x * (1.f + m[1024 + d]) + m[d], h1 = v.y * (1.f + m[1024 + d + 1]) + m[d + 1];
      float h2 = v.z * (1.f + m[1024 + d + 2]) + m[d + 2], h3 = v.w * (1.f + m[1024 + d + 3]) + m[d + 3];
      uint2 o; o.x = pack2(h0, h1); o.y = pack2(h2, h3);
      *(uint2*)(p.h + (size_t)tok * 1024 + d) = o;
    }
  }
}

DEVI bool xcd_tile(int it, int nM, int nN, int& mt, int& nt) {
  const int b = BID(), per = gridDim.x >> 3;
  const int t = (it * 8 + (b & 7)) * per + (b >> 3);
  if (t >= nM * nN) return false;
  const int width = 8 * nN, g = t / width, first_m = g * 8;
  const int gsz = min(nM - first_m, 8), tt = t - g * width;
  mt = first_m + tt % gsz; nt = tt / gsz;
  return true;
}

DEVI void phase_g1(const Params& p, int l, char* smem) {
  const int nM256 = 63, nM128 = (NT - 63 * 256) / 128, nN = INWP / 128;
  bf16_t* proj = p.proj; float* gates = p.gates; const float* gate_b = p.gate_b + l * 32;
  auto epi = [&](int m, int n, const f32x4& v) {
    if (n < 8192) *(uint2*)(proj + (size_t)m * 8192 + n) = pack4(v);
    else if (n < 8224) *(f32x4*)(gates + m * 32 + (n - 8192)) = v + *(const f32x4*)(gate_b + (n - 8192));
  };
  for (int it = 0;; ++it) {
    int mt, nt;
    if (!xcd_tile(it, nM256, nN, mt, nt)) break;
    gemm256g(p.h, p.wt_in, mt * 256, nt * 128, smem, epi, proj, 8192, 8192);
  }
  for (int it = 0;; ++it) {
    int mt, nt;
    if (!xcd_tile(it, nM128, nN, mt, nt)) break;
    gemm128g(p.h, p.wt_in, nM256 * 256 + mt * 128, nt * 128, smem, epi);
  }
}

DEVI void conv_tap(float (&acc)[8], const uint4& u, const float4& w0, const float4& w1) {
  acc[0] += lo2f(u.x) * w0.x; acc[1] += hi2f(u.x) * w0.y; acc[2] += lo2f(u.y) * w0.z; acc[3] += hi2f(u.y) * w0.w;
  acc[4] += lo2f(u.z) * w1.x; acc[5] += hi2f(u.z) * w1.y; acc[6] += lo2f(u.w) * w1.z; acc[7] += hi2f(u.w) * w1.w;
}
DEVI void phase_conv(const Params& p, int l, char* smem) {
  const int tid = TID();
  const size_t gtid = (size_t)BID() * 256 + tid, gstride = (size_t)gridDim.x * 256;
  const float* cw = p.qk_conv_w + (size_t)l * 9 * 2048;
  const float* cb = p.qk_conv_b + (size_t)l * 2048;
  const bf16_t* __restrict__ proj = p.proj;
  for (size_t i = gtid; i < (size_t)256 * 2 * 256; i += gstride) {
    const int cg = (int)(i & 255), seg = (int)((i >> 8) & 1), grow = (int)(i >> 9), b = grow >> 7, r = grow & 127, ch = cg * 8;
    float4 w[9][2];
#pragma unroll
    for (int t = 0; t < 9; ++t) { w[t][0] = *(const float4*)(cw + t * 2048 + ch); w[t][1] = *(const float4*)(cw + t * 2048 + ch + 4); }
    const float4 b0 = *(const float4*)(cb + ch), b1 = *(const float4*)(cb + ch + 4);
    const bool v0 = r > 0, v2 = r < 127;
    const bf16_t* row1 = proj + (size_t)(b * 8192 + r * 64) * 8192 + ch;
    const bf16_t* row0 = row1 - (size_t)64 * 8192;
    const bf16_t* row2 = row1 + (size_t)64 * 8192;
    const uint4 zz = uint4{0, 0, 0, 0};
    const int c0 = seg * 32;
    uint4 L0 = zz, L1 = zz, L2 = zz, M0, M1, M2;
    if (c0 > 0) {
      L0 = v0 ? *(const uint4*)(row0 + (size_t)(c0 - 1) * 8192) : zz;
      L1 = *(const uint4*)(row1 + (size_t)(c0 - 1) * 8192);
      L2 = v2 ? *(const uint4*)(row2 + (size_t)(c0 - 1) * 8192) : zz;
    }
    M0 = v0 ? *(const uint4*)(row0 + (size_t)c0 * 8192) : zz;
    M1 = *(const uint4*)(row1 + (size_t)c0 * 8192);
    M2 = v2 ? *(const uint4*)(row2 + (size_t)c0 * 8192) : zz;
    const float sc = ch < 1024 ? 0.08838834764831845f : 1.f;
    bf16_t* dst = (ch < 1024 ? p.q + ch : p.k + (ch - 1024)) + (size_t)(b * 8192 + r * 64) * 1024;
#pragma unroll 1
    for (int cc = c0; cc < c0 + 32; cc += 4) {
      uint4 R0[4], R1[4], R2[4];
#pragma unroll
      for (int j = 0; j < 4; ++j) {
        const int cn = cc + j + 1;
        const bool vc = cn < 64;
        R0[j] = (vc && v0) ? *(const uint4*)(row0 + (size_t)cn * 8192) : zz;
        R1[j] = vc ? *(const uint4*)(row1 + (size_t)cn * 8192) : zz;
        R2[j] = (vc && v2) ? *(const uint4*)(row2 + (size_t)cn * 8192) : zz;
      }
#pragma unroll
      for (int j = 0; j < 4; ++j) {
        float acc[8] = {b0.x, b0.y, b0.z, b0.w, b1.x, b1.y, b1.z, b1.w};
        conv_tap(acc, L0, w[0][0], w[0][1]); conv_tap(acc, M0, w[1][0], w[1][1]); conv_tap(acc, R0[j], w[2][0], w[2][1]);
        conv_tap(acc, L1, w[3][0], w[3][1]); conv_tap(acc, M1, w[4][0], w[4][1]); conv_tap(acc, R1[j], w[5][0], w[5][1]);
        conv_tap(acc, L2, w[6][0], w[6][1]); conv_tap(acc, M2, w[7][0], w[7][1]); conv_tap(acc, R2[j], w[8][0], w[8][1]);
#pragma unroll
        for (int q = 0; q < 8; ++q) acc[q] = silu_f(acc[q]) * sc;
        uint4 o; o.x = pack2(acc[0], acc[1]); o.y = pack2(acc[2], acc[3]); o.z = pack2(acc[4], acc[5]); o.w = pack2(acc[6], acc[7]);
        *(uint4*)(dst + (size_t)(cc + j) * 1024) = o;
        L0 = M0; L1 = M1; L2 = M2; M0 = R0[j]; M1 = R1[j]; M2 = R2[j];
      }
    }
  }
  for (size_t i = (size_t)NTX * 256 + gtid; i < (size_t)NT * 256; i += gstride) {
    int tok = (int)(i >> 8), ch = (int)(i & 255) * 8;
    float acc[8];
#pragma unroll
    for (int j = 0; j < 8; ++j) acc[j] = cb[ch + j];
    int t = (tok - NTX) & 255;
#pragma unroll
    for (int dj = 0; dj < 3; ++dj) {
      int tt = t + dj - 1;
      if (tt >= 0 && tt < 256) {
        uint4 u = *(const uint4*)(p.proj + (size_t)(tok + dj - 1) * 8192 + ch);
        const float* w = cw + (3 + dj) * 2048 + ch;
        conv_tap(acc, u, *(const float4*)w, *(const float4*)(w + 4));
      }
    }
    float sc = ch < 1024 ? 0.08838834764831845f : 1.f;
#pragma unroll
    for (int j = 0; j < 8; ++j) acc[j] = silu_f(acc[j]) * sc;
    uint4 o; o.x = pack2(acc[0], acc[1]); o.y = pack2(acc[2], acc[3]); o.z = pack2(acc[4], acc[5]); o.w = pack2(acc[6], acc[7]);
    if (ch < 1024) *(uint4*)(p.q + (size_t)tok * 1024 + ch) = o;
    else *(uint4*)(p.k + (size_t)tok * 1024 + ch - 1024) = o;
  }
  const int lane = tid & 63;
  const int gw = (BID() * 256 + tid) >> 6, nw = gridDim.x * 4;
  for (int tok = gw; tok < NT; tok += nw) {
    const bf16_t* src = p.proj + (size_t)tok * 8192 + 5120;
    uint4 u0 = *(const uint4*)(src + lane * 8), u1 = *(const uint4*)(src + 512 + lane * 8);
    unsigned w[8] = {u0.x, u0.y, u0.z, u0.w, u1.x, u1.y, u1.z, u1.w};
    float g[16]; float s = 0.f;
#pragma unroll
    for (int j = 0; j < 8; ++j) { g[2 * j] = gelu_f(lo2f(w[j])); g[2 * j + 1] = gelu_f(hi2f(w[j])); s += g[2 * j] + g[2 * j + 1]; }
    float mu = wave_sum(s) * (1.f / 1024.f);
    float v = 0.f;
#pragma unroll
    for (int j = 0; j < 16; ++j) { float d = g[j] - mu; v += d * d; }
    v = wave_sum(v) * (1.f / 1024.f);
    if (lane == 0) { p.sgu_stats[tok * 2] = mu; p.sgu_stats[tok * 2 + 1] = rsqrtf(v + LN_EPS); }
  }
}

DEVI void store_acc_bf16(bf16_t* dst, const f32x4 (&acc)[2][8], int rowbase, int fr, int fq) {
#pragma unroll
  for (int mt = 0; mt < 2; ++mt)
#pragma unroll
    for (int nt = 0; nt < 8; ++nt) *(uint2*)(dst + (rowbase + mt * 16 + fr) * 128 + nt * 16 + fq * 4) = pack4(acc[mt][nt]);
}

DEVI void mloc_item(const Params& p, int item, char* smem) {
  int tid_ = TID(); asm volatile("" : "+v"(tid_));
  const int tid = tid_, lane = tid & 63, wid = tid >> 6, fr = lane & 15, fq = lane >> 4;
  const int cidx = item % 66, bh = item / 66, hh = bh & 7, b = bh >> 3;
  const int tok0 = tok_base(b, cidx);
  char* KT = smem; char* VT = smem + 34816;
  float* fa = (float*)(smem + 69632);
  float *fcf = fa, *fif = fa + 128, *fcb = fa + 256, *fib = fa + 384, *bf = fa + 512, *bb = fa + 640, *wlf = fa + 768, *wlb = fa + 896;
  __syncthreads();
  if (tid < 128) {
    const float* g = p.gates + (size_t)(tok0 + tid) * 32;
    fif[tid] = g[hh]; fcf[tid] = logsigmoid_f(g[8 + hh]); fib[tid] = g[16 + hh]; fcb[tid] = logsigmoid_f(g[24 + hh]);
  }
  __syncthreads();
  if (tid < 128) { float s = 0.f;
#pragma unroll 8
    for (int i = 0; i <= tid; ++i) s += fcf[i]; bf[tid] = s; }
  else { int t = tid - 128; float s = 0.f;
#pragma unroll 8
    for (int i = 127; i >= t; --i) s += fcb[i]; bb[t] = s; }
  __syncthreads();
  float gf = bf[127], gb = bb[0], mlf, mlb;
  {
    float m = -3.0e38f;
    if (tid < 128) {
_Pragma("unroll 4")
 for (int i = 0; i < 128; ++i) m = fmaxf(m, gf - bf[i] + fif[i]); wlf[tid] = __expf(gf - bf[tid] + fif[tid] - m); mlf = m; }
    else { int t = tid - 128;
_Pragma("unroll 4")
 for (int i = 0; i < 128; ++i) m = fmaxf(m, gb - bb[i] + fib[i]); wlb[t] = __expf(gb - bb[t] + fib[t] - m); mlb = m; }
  }
  if (tid == 0) { p.cscal[(0 * NITEM + item) * 2] = gf; p.cscal[(0 * NITEM + item) * 2 + 1] = mlf; }
  if (tid == 128) { p.cscal[(1 * NITEM + item) * 2] = gb; p.cscal[(1 * NITEM + item) * 2 + 1] = mlb; }
  __syncthreads();
  const bf16_t* ksrc = p.k + (size_t)tok0 * 1024 + hh * 128;
  const bf16_t* vsrc = p.proj + (size_t)tok0 * 8192 + 2048 + hh * 128;
  {
    TileT tk = tile_loadT(ksrc, 1024, tid);
    tile_putT2(KT, tk, tid, nullptr);
  }
#pragma unroll 1
  for (int dir = 0; dir < 2; ++dir) {
    const float* wl = dir ? wlb : wlf;
    {
      TileT tv = tile_loadT(vsrc, 8192, tid);
      tile_putT2(VT, tv, tid, wl);
    }
    __syncthreads();
    bf16x8 a[2][4];
    load_fragA(a, VT, wid * 32, fr, fq);
    f32x4 acc[2][8];
#pragma unroll
    for (int mt = 0; mt < 2; ++mt)
#pragma unroll
      for (int nt = 0; nt < 8; ++nt) acc[mt][nt] = f32x4{0.f, 0.f, 0.f, 0.f};
    mma_regA(a, KT, acc, fr, fq);
    store_acc_bf16(p.dC + ((size_t)dir * NITEM + item) * 16384, acc, wid * 32, fr, fq);
    if (tid < 128) {
      const bf16_t* kr = (const bf16_t*)KT + tid * 136;
      float s = 0.f;
#pragma unroll 4
      for (int i = 0; i < 128; ++i) s += wl[i] * bf2f(kr[i]);
      p.dn[((size_t)dir * NITEM + item) * 128 + tid] = s;
    }
    __syncthreads();
  }
}

DEVI void sgu_item(const Params& p, int l, int item, char* smem) {
  int tid_ = TID(); asm volatile("" : "+v"(tid_));
  const int tid = tid_, lane = tid & 63, wid = tid >> 6, fr = lane & 15, fq = lane >> 4;
  const int chunk = item >> 3, g = item & 7, tok0 = chunk * 128;
  char* ZT = smem; char* WS = smem + 34816;
  __syncthreads();
  {
    unsigned* dst = (unsigned*)ZT;
    const float* nw = p.sgu_norm_w + l * 1024 + g * 128;
    const int rp = tid & 63, c0 = (tid >> 6) * 32;
    const bf16_t* ra = p.proj + (size_t)(tok0 + 2 * rp) * 8192 + 5120 + g * 128 + c0;
    const float muA = p.sgu_stats[(tok0 + 2 * rp) * 2], rsA = p.sgu_stats[(tok0 + 2 * rp) * 2 + 1];
    const float muB = p.sgu_stats[(tok0 + 2 * rp + 1) * 2], rsB = p.sgu_stats[(tok0 + 2 * rp + 1) * 2 + 1];
#pragma unroll 2
    for (int i = 0; i < 4; ++i) {
      const uint4 ua = *(const uint4*)(ra + i * 8), ub = *(const uint4*)(ra + 8192 + i * 8);
      const unsigned wa[4] = {ua.x, ua.y, ua.z, ua.w}, wb[4] = {ub.x, ub.y, ub.z, ub.w};
#pragma unroll
      for (int k = 0; k < 4; ++k) {
        const int col = c0 + i * 8 + 2 * k;
        const float n0 = nw[col], n1 = nw[col + 1];
        const unsigned lo = pack2((gelu_f(lo2f(wa[k])) - muA) * rsA * n0, (gelu_f(lo2f(wb[k])) - muB) * rsB * n0);
        const unsigned hi = pack2((gelu_f(hi2f(wa[k])) - muA) * rsA * n1, (gelu_f(hi2f(wb[k])) - muB) * rsB * n1);
        dst[col * 68 + rp] = lo;
        dst[(col + 1) * 68 + rp] = hi;
      }
    }
    const float* ws = p.sgu_w + ((size_t)l * 8 + g) * 16384;
#pragma unroll 4
    for (int i = 0; i < 16; ++i) {
      int c = tid + i * 256, row = c >> 5, c4 = (c & 31) * 4;
      float4 v = *(const float4*)(ws + row * 128 + c4);
      uint2 o; o.x = pack2(v.x, v.y); o.y = pack2(v.z, v.w);
      *(uint2*)(WS + row * 272 + c4 * 2) = o;
    }
  }
  __syncthreads();
  bf16x8 a[2][4];
  load_fragA(a, WS, wid * 32, fr, fq);
  f32x4 acc[2][8];
#pragma unroll
  for (int mt = 0; mt < 2; ++mt)
#pragma unroll
    for (int nt = 0; nt < 8; ++nt) acc[mt][nt] = f32x4{0.f, 0.f, 0.f, 0.f};
  mma_regA(a, ZT, acc, fr, fq);
  const float* bs = p.sgu_b + ((size_t)l * 8 + g) * 128;
#pragma unroll
  for (int mt = 0; mt < 2; ++mt) {
    const int pp = wid * 32 + mt * 16 + fr;
    const float bsv = bs[pp];
#pragma unroll
    for (int nt = 0; nt < 8; ++nt) {
      const int cc = g * 128 + nt * 16 + fq * 4;
      f32x4 u = unpack4(*(const uint2*)(p.proj + (size_t)(tok0 + pp) * 8192 + 4096 + cc));
      f32x4 o = f32x4{gelu_f(u[0]), gelu_f(u[1]), gelu_f(u[2]), gelu_f(u[3])} * (acc[mt][nt] + bsv);
      *(uint2*)(p.hB + (size_t)(tok0 + pp) * 1024 + cc) = pack4(o);
    }
  }
}

DEVI void phase_mloc(const Params& p, int l, char* smem) {
  for (int item = BID(); item < 2 * NITEM; item += gridDim.x) {
    if (item < NITEM) mloc_item(p, item, smem);
    else sgu_item(p, l, item - NITEM, smem);
  }
}

DEVI void phase_scan(const Params& p) {
  const size_t gtid = (size_t)BID() * 256 + TID(), gstride = (size_t)gridDim.x * 256;
  for (size_t i = gtid; i < 32 * 2048; i += gstride) {
    int chain = (int)(i >> 11), e = (int)(i & 2047);
    int dir = chain >> 4, bh = chain & 15;
    float C[8];
#pragma unroll
    for (int j = 0; j < 8; ++j) C[j] = 0.f;
    float nacc[8];
#pragma unroll
    for (int j = 0; j < 8; ++j) nacc[j] = 0.f;
    float m = -1e30f;
#pragma unroll 11
    for (int j = 0; j < 66; ++j) {
      int cidx = dir == 0 ? (j < 2 ? 64 + j : j - 2) : (j < 2 ? 65 - j : 65 - j);
      size_t it = (size_t)dir * NITEM + bh * 66 + cidx;
      uint4 o; o.x = pack2(C[0], C[1]); o.y = pack2(C[2], C[3]); o.z = pack2(C[4], C[5]); o.w = pack2(C[6], C[7]);
      *(uint4*)(p.Cin + it * 16384 + e * 8) = o;
      if (e == 0) p.min_[it] = m;
      uint4 u = *(const uint4*)(p.dC + it * 16384 + e * 8);
      float g = p.cscal[it * 2], ml = p.cscal[it * 2 + 1];
      float mn = fmaxf(g + m, ml);
      float a = __expf(g + m - mn), s = __expf(ml - mn);
      C[0] = a * C[0] + s * lo2f(u.x); C[1] = a * C[1] + s * hi2f(u.x);
      C[2] = a * C[2] + s * lo2f(u.y); C[3] = a * C[3] + s * hi2f(u.y);
      C[4] = a * C[4] + s * lo2f(u.z); C[5] = a * C[5] + s * hi2f(u.z);
      C[6] = a * C[6] + s * lo2f(u.w); C[7] = a * C[7] + s * hi2f(u.w);
      if (e < 16) {
        float4 d0 = *(const float4*)(p.dn + it * 128 + e * 8), d1 = *(const float4*)(p.dn + it * 128 + e * 8 + 4);
        *(float4*)(p.nin + it * 128 + e * 8) = float4{nacc[0], nacc[1], nacc[2], nacc[3]};
        *(float4*)(p.nin + it * 128 + e * 8 + 4) = float4{nacc[4], nacc[5], nacc[6], nacc[7]};
        nacc[0] = a * nacc[0] + s * d0.x; nacc[1] = a * nacc[1] + s * d0.y; nacc[2] = a * nacc[2] + s * d0.z; nacc[3] = a * nacc[3] + s * d0.w;
        nacc[4] = a * nacc[4] + s * d1.x; nacc[5] = a * nacc[5] + s * d1.y; nacc[6] = a * nacc[6] + s * d1.z; nacc[7] = a * nacc[7] + s * d1.w;
      }
      m = mn;
    }
  }
}

DEVI bf16x8 scale_frag(bf16x8 a, float s) {
  asm volatile("" : "+v"(a));
  typedef unsigned u32x4_t __attribute__((ext_vector_type(4)));
  u32x4_t w = __builtin_bit_cast(u32x4_t, a), o;
#pragma unroll
  for (int j = 0; j < 4; ++j) o[j] = pack2(lo2f(w[j]) * s, hi2f(w[j]) * s);
  return __builtin_bit_cast(bf16x8, o);
}

DEVI void mout_item(const Params& p, int l, int item, char* smem) {
  int tid_ = TID(); asm volatile("" : "+v"(tid_));
  const int tid = tid_, lane = tid & 63, wid = tid >> 6, fr = lane & 15, fq = lane >> 4;
  const int cidx = item % 66, bh = item / 66, hh = bh & 7, b = bh >> 3;
  const int tok0 = tok_base(b, cidx);
  char* B0 = smem; char* B1 = smem + 34816;
  float* fa = (float*)(smem + 69632);
  float *fcf = fa, *fif = fa + 128, *fcb = fa + 256, *fib = fa + 384, *bfv = fa + 512, *bbv = fa + 640, *ef = fa + 768, *eb = fa + 896,
        *mtf = fa + 1024, *mtb = fa + 1152, *af = fa + 1280, *ab = fa + 1408, *qnf = fa + 1536, *qnb = fa + 1664, *cf = fa + 1792, *cb = fa + 1920;
  float* nf = fa + 2048 - 0;
  float* nb = nf + 128;
  __syncthreads();
  const size_t itf = (size_t)0 * NITEM + item, itb = (size_t)1 * NITEM + item;
  if (tid < 128) {
    const float* g = p.gates + (size_t)(tok0 + tid) * 32;
    fif[tid] = g[hh]; fcf[tid] = logsigmoid_f(g[8 + hh]); fib[tid] = g[16 + hh]; fcb[tid] = logsigmoid_f(g[24 + hh]);
    nf[tid] = p.nin[itf * 128 + tid]; nb[tid] = p.nin[itb * 128 + tid];
  }
  bf16x8 qa[2][4];
  {
    const bf16_t* qsrc = p.q + (size_t)tok0 * 1024 + hh * 128;
#pragma unroll
    for (int mt = 0; mt < 2; ++mt)
#pragma unroll
      for (int ks = 0; ks < 4; ++ks) qa[mt][ks] = *(const bf16x8*)(qsrc + (size_t)(wid * 32 + mt * 16 + fr) * 1024 + ks * 32 + fq * 8);
  }
  {
    Tile8 tk = tile_load(p.k + (size_t)tok0 * 1024 + hh * 128, 1024, tid);
    TileT tv = tile_loadT(p.proj + (size_t)tok0 * 8192 + 2048 + hh * 128, 8192, tid);
    tile_put_R(B0, tk, tid);
    tile_putT2(B1, tv, tid, nullptr);
  }
  const float m_f = p.min_[itf], m_b = p.min_[itb];
  __syncthreads();
  if (tid < 128) {
    float run = 0.f, pm = -3.0e38f, e = 0.f;
#pragma unroll 8
    for (int i = 0; i <= tid; ++i) { run += fcf[i]; e = fif[i] - run; pm = fmaxf(pm, e); }
    float mt = fmaxf(run + m_f, run + pm);
    bfv[tid] = run; ef[tid] = e; mtf[tid] = mt; af[tid] = __expf(run + m_f - mt);
  } else {
    int t = tid - 128;
    float run = 0.f, pm = -3.0e38f, e = 0.f;
#pragma unroll 8
    for (int i = 127; i >= t; --i) { run += fcb[i]; e = fib[i] - run; pm = fmaxf(pm, e); }
    float mt = fmaxf(run + m_b, run + pm);
    bbv[t] = run; eb[t] = e; mtb[t] = mt; ab[t] = __expf(run + m_b - mt);
  }
  float qn_f[2], qn_b[2];
#pragma unroll
  for (int mt = 0; mt < 2; ++mt) {
    float sf = 0.f, sb = 0.f;
#pragma unroll
    for (int ks = 0; ks < 4; ++ks) {
#pragma unroll
      for (int j = 0; j < 8; ++j) {
        float qv = bf2f((bf16_t)qa[mt][ks][j]);
        sf += qv * nf[ks * 32 + fq * 8 + j]; sb += qv * nb[ks * 32 + fq * 8 + j];
      }
      asm volatile("" ::: "memory");
    }
    sf += __shfl_xor(sf, 16); sf += __shfl_xor(sf, 32);
    sb += __shfl_xor(sb, 16); sb += __shfl_xor(sb, 32);
    qn_f[mt] = sf; qn_b[mt] = sb;
  }
  f32x4 sF[2][8];
#pragma unroll
  for (int mt = 0; mt < 2; ++mt)
#pragma unroll
    for (int nt = 0; nt < 8; ++nt) sF[mt][nt] = f32x4{0.f, 0.f, 0.f, 0.f};
  mma_regA(qa, B0, sF, fr, fq);
  __syncthreads();
  float cfv[2], cbv[2];
  {
    const int wid2 = __builtin_amdgcn_readfirstlane(wid) * 2;
    float xf[2], xb[2], rsF[2], rsB[2], dgF[2], dgB[2];
#pragma unroll
    for (int mt = 0; mt < 2; ++mt) {
      const int tau = wid * 32 + mt * 16 + fr;
      xf[mt] = bfv[tau] - mtf[tau]; xb[mt] = bbv[tau] - mtb[tau];
      rsF[mt] = 0.f; rsB[mt] = 0.f; dgF[mt] = 0.f; dgB[mt] = 0.f;
    }
#pragma unroll
    for (int nt = 0; nt < 8; ++nt) {
      const f32x4 e_f = *(const f32x4*)(ef + nt * 16 + fq * 4), e_b = *(const f32x4*)(eb + nt * 16 + fq * 4);
#pragma unroll
      for (int mt = 0; mt < 2; ++mt) {
        const int rel = nt - (wid2 + mt);
        if (rel < 0) {
#pragma unroll
          for (int r = 0; r < 4; ++r) { float v = sF[mt][nt][r] * __expf(xf[mt] + e_f[r]); rsF[mt] += v; sF[mt][nt][r] = v; }
        } else if (rel > 0) {
#pragma unroll
          for (int r = 0; r < 4; ++r) { float v = sF[mt][nt][r] * __expf(xb[mt] + e_b[r]); rsB[mt] += v; sF[mt][nt][r] = v; }
        } else {
#pragma unroll
          for (int r = 0; r < 4; ++r) {
            const int sg = fq * 4 + r;
            float s0 = sF[mt][nt][r];
            float vf = s0 * __expf(xf[mt] + e_f[r]), vb = s0 * __expf(xb[mt] + e_b[r]);
            if (sg < fr) { rsF[mt] += vf; sF[mt][nt][r] = vf; }
            else if (sg > fr) { rsB[mt] += vb; sF[mt][nt][r] = vb; }
            else { dgF[mt] = vf; dgB[mt] = vb; sF[mt][nt][r] = 0.f; }
          }
        }
      }
    }
    bf16_t* P = (bf16_t*)B0;
#pragma unroll
    for (int mt = 0; mt < 2; ++mt) {
      const int tau = wid * 32 + mt * 16 + fr;
      float a_ = rsF[mt] + dgF[mt], b_ = rsB[mt] + dgB[mt];
      a_ += __shfl_xor(a_, 16); a_ += __shfl_xor(a_, 32);
      b_ += __shfl_xor(b_, 16); b_ += __shfl_xor(b_, 32);
      const float denf = af[tau] * qn_f[mt] + a_, denb = ab[tau] * qn_b[mt] + b_;
      const float rf = frcp(fmaxf(fabsf(denf), __expf(-mtf[tau])));
      const float rb = frcp(fmaxf(fabsf(denb), __expf(-mtb[tau])));
      cfv[mt] = rf * af[tau]; cbv[mt] = rb * ab[tau];
      const float dg = rf * dgF[mt] + rb * dgB[mt];
#pragma unroll
      for (int nt = 0; nt < 8; ++nt) {
        const int rel = nt - (wid2 + mt);
        f32x4 pv;
#pragma unroll
        for (int r = 0; r < 4; ++r) {
          const int sg = fq * 4 + r;
          const float v = sF[mt][nt][r];
          pv[r] = rel < 0 ? rf * v : (rel > 0 ? rb * v : (sg < fr ? rf * v : (sg > fr ? rb * v : dg)));
        }
        *(uint2*)(P + tau * 136 + nt * 16 + fq * 4) = pack4(pv);
      }
      asm volatile("" ::: "memory");
    }
  }
  __syncthreads();
  f32x4 O[2][8];
#pragma unroll
  for (int mt = 0; mt < 2; ++mt)
#pragma unroll
    for (int nt = 0; nt < 8; ++nt) O[mt][nt] = f32x4{0.f, 0.f, 0.f, 0.f};
  {
    bf16x8 pa[2][4];
    load_fragA(pa, B0, wid * 32, fr, fq);
    mma_regA(pa, B1, O, fr, fq);
  }
  __syncthreads();
  {
    Tile8 tcf = tile_load(p.Cin + itf * 16384, 128, tid);
    Tile8 tcb = tile_load(p.Cin + itb * 16384, 128, tid);
    tile_put_R(B0, tcf, tid);
    tile_put_R(B1, tcb, tid);
  }
  __syncthreads();
  {
    bf16x8 qs[2][4];
#pragma unroll
    for (int ks = 0; ks < 4; ++ks) { qs[0][ks] = scale_frag(qa[0][ks], cfv[0]); qs[1][ks] = scale_frag(qa[1][ks], cfv[1]); }
    mma_regA(qs, B0, O, fr, fq);
#pragma unroll
    for (int ks = 0; ks < 4; ++ks) { qs[0][ks] = scale_frag(qa[0][ks], cbv[0]); qs[1][ks] = scale_frag(qa[1][ks], cbv[1]); }
    mma_regA(qs, B1, O, fr, fq);
  }
  const float* nw = p.mlstm_norm_w + l * 1024 + hh * 128;
#pragma unroll
  for (int mt = 0; mt < 2; ++mt) {
    const int tau = wid * 32 + mt * 16 + fr;
    float s = 0.f;
#pragma unroll
    for (int nt = 0; nt < 8; ++nt) s += O[mt][nt][0] + O[mt][nt][1] + O[mt][nt][2] + O[mt][nt][3];
    s += __shfl_xor(s, 16); s += __shfl_xor(s, 32);
    const float mu = s * (1.f / 128.f);
    float v = 0.f;
#pragma unroll
    for (int nt = 0; nt < 8; ++nt)
#pragma unroll
      for (int r = 0; r < 4; ++r) { float d = O[mt][nt][r] - mu; v += d * d; }
    v += __shfl_xor(v, 16); v += __shfl_xor(v, 32);
    const float rs = rsqrtf(v * (1.f / 128.f) + LN_EPS);
    const size_t tok = (size_t)(tok0 + tau);
#pragma unroll
    for (int nt = 0; nt < 8; ++nt) {
      const int vv = nt * 16 + fq * 4;
      const f32x4 og = sigmoid4(unpack4(*(const uint2*)(p.proj + tok * 8192 + 3072 + hh * 128 + vv)));
      const f32x4 nw4 = *(const f32x4*)(nw + vv);
      *(uint2*)(p.hA + tok * 1024 + hh * 128 + vv) = pack4(og * (O[mt][nt] - mu) * rs * nw4);
    }
    asm volatile("" ::: "memory");
  }
}

DEVI void phase_mout(const Params& p, int l, char* smem) {
  const int nG = (NT / 96) * 8;
  const float* bb = p.branch_b + l * 2048 + 1024;
  const int nb = gridDim.x, bid = BID();
  for (int item = bid; item < NITEM; item += nb) mout_item(p, l, item, smem);
  const int n_extra = NITEM % nb, n_light = nb - n_extra;
  if (bid >= n_extra) {
    for (int it = bid - n_extra; it < nG; it += n_light) {
      int mt = it % (NT / 96), nt = it / (NT / 96);
      const bf16_t* proj = p.proj; float* r = p.r;
      gemm96(p.hB, p.wt_pb, mt * 96, nt * 128, smem, [&](int m, int n, const f32x4& v) {
        f32x4 g = unpack4(*(const uint2*)(proj + (size_t)m * 8192 + 7168 + n)) + *(const f32x4*)(bb + n);
        *(f32x4*)(r + (size_t)m * 1024 + n) = sigmoid4(g) * v;
      });
    }
  }
}

DEVI void phase_g2a(const Params& p, int l, char* smem) {
  const int nM = NT / 96;
  const float* ba = p.branch_b + l * 2048;
  const bf16_t* proj = p.proj; const float* r = p.r; bf16_t* merged = p.merged;
  for (int it = 0;; ++it) {
    int mt, nt;
    if (!xcd_tile(it, nM, 8, mt, nt)) break;
    gemm96(p.hA, p.wt_pa, mt * 96, nt * 128, smem, [&](int m, int n, const f32x4& v) {
      f32x4 g = unpack4(*(const uint2*)(proj + (size_t)m * 8192 + 6144 + n)) + *(const f32x4*)(ba + n);
      *(uint2*)(merged + (size_t)m * 1024 + n) = pack4(sigmoid4(g) * v + *(const f32x4*)(r + (size_t)m * 1024 + n));
    });
  }
}

DEVI void phase_g3(const Params& p, int l, char* smem) {
  const int nM = NT / 96;
  const float* z = p.z; float* r = p.r; const float* mod = p.mod + (size_t)l * 3 * 6144;
  for (int it = 0;; ++it) {
    int mt, nt;
    if (!xcd_tile(it, nM, 8, mt, nt)) break;
    gemm96(p.merged, p.wt_out, mt * 96, nt * 128, smem, [&](int m, int n, const f32x4& v) {
      *(f32x4*)(r + (size_t)m * 1024 + n) = DN_ALPHA * *(const f32x4*)(z + (size_t)m * 1024 + n) + *(const f32x4*)(mod + mod_index(m) * 6144 + 2048 + n) * v;
    });
  }
}

DEVI void wave_ln(float (&v)[16], const float* w, const float* bsh, int lane) {
  float s = 0.f;
#pragma unroll
  for (int j = 0; j < 16; ++j) s += v[j];
  float mu = wave_sum(s) * (1.f / 1024.f);
  float q = 0.f;
#pragma unroll
  for (int j = 0; j < 16; ++j) { float d = v[j] - mu; q += d * d; }
  float rs = rsqrtf(wave_sum(q) * (1.f / 1024.f) + LN_EPS);
#pragma unroll
  for (int j = 0; j < 16; ++j) {
    int d = (j < 8 ? 0 : 512) + lane * 8 + (j & 7);
    v[j] = (v[j] - mu) * rs * w[d] + bsh[d];
  }
}
DEVI void load16(const float* src, int lane, float (&v)[16]) {
  float4 a = *(const float4*)(src + lane * 8), b = *(const float4*)(src + lane * 8 + 4);
  float4 c = *(const float4*)(src + 512 + lane * 8), d = *(const float4*)(src + 512 + lane * 8 + 4);
  v[0] = a.x; v[1] = a.y; v[2] = a.z; v[3] = a.w; v[4] = b.x; v[5] = b.y; v[6] = b.z; v[7] = b.w;
  v[8] = c.x; v[9] = c.y; v[10] = c.z; v[11] = c.w; v[12] = d.x; v[13] = d.y; v[14] = d.z; v[15] = d.w;
}
DEVI void store16(float* dst, int lane, const float (&v)[16]) {
  *(float4*)(dst + lane * 8) = float4{v[0], v[1], v[2], v[3]};
  *(float4*)(dst + lane * 8 + 4) = float4{v[4], v[5], v[6], v[7]};
  *(float4*)(dst + 512 + lane * 8) = float4{v[8], v[9], v[10], v[11]};
  *(float4*)(dst + 512 + lane * 8 + 4) = float4{v[12], v[13], v[14], v[15]};
}
DEVI void store16_mod_bf16(bf16_t* dst, int lane, const float (&v)[16], const float* shift, const float* scale) {
  float h[16];
#pragma unroll
  for (int j = 0; j < 16; ++j) {
    int d = (j < 8 ? 0 : 512) + lane * 8 + (j & 7);
    h[j] = v[j] * (1.f + scale[d]) + shift[d];
  }
  uint4 o0, o1;
  o0.x = pack2(h[0], h[1]); o0.y = pack2(h[2], h[3]); o0.z = pack2(h[4], h[5]); o0.w = pack2(h[6], h[7]);
  o1.x = pack2(h[8], h[9]); o1.y = pack2(h[10], h[11]); o1.z = pack2(h[12], h[13]); o1.w = pack2(h[14], h[15]);
  *(uint4*)(dst + lane * 8) = o0;
  *(uint4*)(dst + 512 + lane * 8) = o1;
}

DEVI void phase_ln1(const Params& p, int l) {
  const int lane = TID() & 63;
  const int gw = (BID() * 256 + TID()) >> 6, nw = gridDim.x * 4;
  for (int tok = gw; tok < NT; tok += nw) {
    float v[16];
    load16(p.r + (size_t)tok * 1024, lane, v);
    wave_ln(v, p.ln_w + (size_t)(l * 2 + 0) * 1024, p.ln_b + (size_t)(l * 2 + 0) * 1024, lane);
    store16(p.z + (size_t)tok * 1024, lane, v);
    const float* m = p.mod + ((size_t)l * 3 + mod_index(tok)) * 6144;
    store16_mod_bf16(p.h + (size_t)tok * 1024, lane, v, m + 3 * 1024, m + 4 * 1024);
  }
}

DEVI void phase_g4(const Params& p, int l, char* smem) {
  bf16_t* qry = p.qry;
  auto epi = [&](int m, int n, const f32x4& v) { *(uint2*)(qry + (size_t)m * 2048 + n) = pack4(v); };
  for (int it = 0;; ++it) {
    int mt, nt;
    if (!xcd_tile(it, 64, 16, mt, nt)) break;
    gemm256g(p.h, p.wt_q, mt * 256, nt * 128, smem, epi, qry, 2048, 2048);
  }
  for (int it = 0;; ++it) {
    int mt, nt;
    if (!xcd_tile(it, (NT - 16384) / 128, 16, mt, nt)) break;
    gemm128g(p.h, p.wt_q, 16384 + mt * 128, nt * 128, smem, epi);
  }
}

DEVI unsigned ord_enc(float f) { unsigned u = __float_as_uint(f); return (u & 0x80000000u) ? ~u : (u | 0x80000000u); }
DEVI float ord_dec(unsigned k) { unsigned u = (k & 0x80000000u) ? (k ^ 0x80000000u) : ~k; return __uint_as_float(u); }
DEVI unsigned umed3(unsigned a, unsigned b, unsigned c) { unsigned d; asm("v_med3_u32 %0, %1, %2, %3" : "=v"(d) : "v"(a), "v"(b), "v"(c)); return d; }
DEVI void ins16(unsigned (&r)[16], unsigned x) {
#pragma unroll
  for (int i = 15; i >= 1; --i) r[i] = umed3(r[i - 1], r[i], x);
  r[0] = max(r[0], x);
}

DEVI void merge16(unsigned (&r)[16], const unsigned (&o)[16]) {
#pragma unroll
  for (int i = 0; i < 16; ++i) r[i] = max(r[i], o[15 - i]);
#pragma unroll
  for (int st = 8; st >= 1; st >>= 1)
#pragma unroll
    for (int i = 0; i < 16; ++i)
      if ((i & st) == 0) { unsigned hi = max(r[i], r[i + st]), lo = min(r[i], r[i + st]); r[i] = hi; r[i + st] = lo; }
}
DEVI void phase_topk(const Params& p, int l, char* smem) {
  const int tid = TID(), lane = tid & 63, wid = tid >> 6, fr = lane & 15, fq = lane >> 4;
  const int hh = BID() & 7;
  __syncthreads();
  {
    const bf16_t* ksrc = p.keys + (size_t)(l & 1) * 262144 + (size_t)hh * 2 * 16384;
    Tile8 k0 = tile_load(ksrc, 128, tid);
    Tile8 k1 = tile_load(ksrc + 16384, 128, tid);
    tile_put_R(smem, k0, tid);
    tile_put_R(smem + 34816, k1, tid);
  }
  __syncthreads();
  unsigned* tab = (unsigned*)(smem + 69632) + (size_t)(wid * 16 + fr) * 33;
  const int ntg = NT / 16, tg_stride = (int)(gridDim.x >> 3) * 4;
  for (int tg = (BID() >> 3) * 4 + wid; tg < ntg; tg += tg_stride) {
    const int t0 = tg * 16;
    unsigned top[2][16];
#pragma unroll
    for (int ph = 0; ph < 2; ++ph) {
      const char* kb = smem + ph * 34816;
      const bf16_t* qb = p.qry + (size_t)(t0 + fr) * 2048 + hh * 256 + ph * 128;
      f32x4 acc[8];
#pragma unroll
      for (int mt = 0; mt < 8; ++mt) acc[mt] = f32x4{0.f, 0.f, 0.f, 0.f};
#pragma unroll
      for (int ks = 0; ks < 4; ++ks) {
        bf16x8 bq = *(const bf16x8*)(qb + ks * 32 + fq * 8);
#pragma unroll
        for (int mt = 0; mt < 8; ++mt) {
          bf16x8 ak = *(const bf16x8*)(kb + (mt * 16 + fr) * 272 + ks * 64 + fq * 16);
          acc[mt] = __builtin_amdgcn_mfma_f32_16x16x32_bf16(ak, bq, acc[mt], 0, 0, 0);
        }
      }
#pragma unroll
      for (int i = 0; i < 16; ++i) top[ph][i] = 0u;
#pragma unroll
      for (int mt = 0; mt < 8; ++mt)
#pragma unroll
        for (int r = 0; r < 4; ++r) {
          unsigned key = (ord_enc(acc[mt][r]) & ~0x7Fu) | (unsigned)(127 - (mt * 16 + fq * 4 + r));
          ins16(top[ph], key);
        }
#pragma unroll
      for (int st = 16; st <= 32; st <<= 1) {
        unsigned o[16];
#pragma unroll
        for (int i = 0; i < 16; ++i) o[i] = (unsigned)__shfl_xor((int)top[ph][i], st);
        merge16(top[ph], o);
      }
    }
    unsigned cd[16];
#pragma unroll
    for (int i = 0; i < 16; ++i) cd[i] = 0u;
    float v0[16], v1[16];
#pragma unroll
    for (int i = 0; i < 16; ++i) {
      v0[i] = ord_dec(top[0][i] & ~0x7Fu); v1[i] = ord_dec(top[1][i] & ~0x7Fu);
      tab[i] = 127u - (top[0][i] & 0x7Fu); tab[16 + i] = 127u - (top[1][i] & 0x7Fu);
    }
#pragma unroll
    for (int a = 0; a < 16; ++a)
#pragma unroll
      for (int bq = 0; bq < 16; ++bq)
        if ((a + 1) * (bq + 1) <= 16) {
          unsigned key = (ord_enc(v0[a] + v1[bq]) & ~0xFFu) | (unsigned)(255 - (a * 16 + bq));
          ins16(cd, key);
        }
    float sv[16];
    int ei[16];
    float mx = ord_dec(cd[0] & ~0xFFu), sum = 0.f;
#pragma unroll
    for (int i = 0; i < 16; ++i) {
      unsigned code = 255u - (cd[i] & 0xFFu);
      sv[i] = __expf(ord_dec(cd[i] & ~0xFFu) - mx);
      sum += sv[i];
      ei[i] = (int)(tab[code >> 4] * 128u + tab[16 + (code & 15u)]);
    }
    float inv = 1.f / sum;
    if (fq == 0) {
      int* di = p.eidx + (size_t)(t0 + fr) * 128 + hh * 16;
      float* dg = p.egate + (size_t)(t0 + fr) * 128 + hh * 16;
#pragma unroll
      for (int i = 0; i < 16; i += 4) {
        *(int4*)(di + i) = int4{ei[i], ei[i + 1], ei[i + 2], ei[i + 3]};
        *(float4*)(dg + i) = float4{sv[i] * inv, sv[i + 1] * inv, sv[i + 2] * inv, sv[i + 3] * inv};
      }
    }
  }
}

typedef float v2f_t __attribute__((ext_vector_type(2)));
DEVI float dot16_fp8(const uint4& a, const float (&x)[16]) {
  const unsigned w[4] = {a.x, a.y, a.z, a.w};
  float s0 = 0.f, s1 = 0.f;
#pragma unroll
  for (int i = 0; i < 4; ++i) {
    v2f_t lo = __builtin_amdgcn_cvt_pk_f32_fp8((int)w[i], false), hi = __builtin_amdgcn_cvt_pk_f32_fp8((int)w[i], true);
    s0 += lo[0] * x[4 * i]; s1 += lo[1] * x[4 * i + 1]; s0 += hi[0] * x[4 * i + 2]; s1 += hi[1] * x[4 * i + 3];
  }
  return s0 + s1;
}
DEVI void axpy16_fp8(float (&o)[16], float c, const uint4& a) {
  const unsigned w[4] = {a.x, a.y, a.z, a.w};
#pragma unroll
  for (int i = 0; i < 4; ++i) {
    v2f_t lo = __builtin_amdgcn_cvt_pk_f32_fp8((int)w[i], false), hi = __builtin_amdgcn_cvt_pk_f32_fp8((int)w[i], true);
    o[4 * i] += c * lo[0]; o[4 * i + 1] += c * lo[1]; o[4 * i + 2] += c * hi[0]; o[4 * i + 3] += c * hi[1];
  }
}
DEVI void load16c(const float* src, int lane, float (&v)[16]) {
#pragma unroll
  for (int i = 0; i < 4; ++i) {
    float4 a = *(const float4*)(src + lane * 16 + i * 4);
    v[4 * i] = a.x; v[4 * i + 1] = a.y; v[4 * i + 2] = a.z; v[4 * i + 3] = a.w;
  }
}
DEVI void store16c(float* dst, int lane, const float (&v)[16]) {
#pragma unroll
  for (int i = 0; i < 4; ++i) *(float4*)(dst + lane * 16 + i * 4) = float4{v[4 * i], v[4 * i + 1], v[4 * i + 2], v[4 * i + 3]};
}

DEVI void phase_gather(const Params& p, int l) {
  const int lane = TID() & 63;
  const int gw = (BID() * 256 + TID()) >> 6, nw = gridDim.x * 4;
  for (int tok = gw; tok < NT; tok += nw) {
    float x[16];
    {
      const bf16_t* hs = p.h + (size_t)tok * 1024 + lane * 16;
      uint4 a0 = *(const uint4*)(hs), a1 = *(const uint4*)(hs + 8);
      x[0] = lo2f(a0.x); x[1] = hi2f(a0.x); x[2] = lo2f(a0.y); x[3] = hi2f(a0.y); x[4] = lo2f(a0.z); x[5] = hi2f(a0.z); x[6] = lo2f(a0.w); x[7] = hi2f(a0.w);
      x[8] = lo2f(a1.x); x[9] = hi2f(a1.x); x[10] = lo2f(a1.y); x[11] = hi2f(a1.y); x[12] = lo2f(a1.z); x[13] = hi2f(a1.z); x[14] = lo2f(a1.w); x[15] = hi2f(a1.w);
    }
    float o[16];
#pragma unroll
    for (int j = 0; j < 16; ++j) o[j] = 0.f;
    const int* ei = p.eidx + (size_t)tok * 128;
    const float* eg = p.egate + (size_t)tok * 128;
    const int myi0 = ei[lane], myi1 = ei[64 + lane];
    const float* esc = p.escale + (l & 1) * 32768;
    const unsigned char* eub = p.eu + (size_t)(l & 1) * 16384 * 1024;
    const unsigned char* evb = p.ev + (size_t)(l & 1) * 16384 * 1024;
    const float mys0 = esc[myi0], mys1 = esc[myi1];
    const float myg0 = eg[lane] * esc[16384 + myi0], myg1 = eg[64 + lane] * esc[16384 + myi1];
#ifdef PROBE_GATHER
#pragma unroll 1
    for (int half4 = 0; half4 < 4; ++half4) {
      const int half = half4 & 1;
      const int myi = half ? myi1 : myi0; const float mys = half ? mys1 : mys0; const float myg = (half ? myg1 : myg0) * 0.5f;
#else
#pragma unroll 1
    for (int half = 0; half < 2; ++half) {
      const int myi = half ? myi1 : myi0; const float mys = half ? mys1 : mys0; const float myg = half ? myg1 : myg0;
#endif
#pragma unroll 1
      for (int e0 = 0; e0 < 64; e0 += 8) {
        uint4 u[8], v[8]; float gt[8], su[8];
#pragma unroll
        for (int j = 0; j < 8; ++j) {
          const int e = __builtin_amdgcn_readlane(myi, e0 + j);
          gt[j] = __builtin_bit_cast(float, __builtin_amdgcn_readlane(__builtin_bit_cast(int, myg), e0 + j));
          su[j] = __builtin_bit_cast(float, __builtin_amdgcn_readlane(__builtin_bit_cast(int, mys), e0 + j));
          u[j] = *(const uint4*)(eub + (size_t)e * 1024 + lane * 16);
          v[j] = *(const uint4*)(evb + (size_t)e * 1024 + lane * 16);
        }
        float d[8];
#pragma unroll
        for (int j = 0; j < 8; ++j) d[j] = dot16_fp8(u[j], x);
#pragma unroll
        for (int of = 32; of > 0; of >>= 1) {
#pragma unroll
          for (int j = 0; j < 8; ++j) d[j] += __shfl_xor(d[j], of);
        }
#pragma unroll
        for (int j = 0; j < 8; ++j) axpy16_fp8(o, gt[j] * gelu_f(su[j] * d[j]), v[j]);
      }
    }
    const float* m = p.mod + ((size_t)l * 3 + mod_index(tok)) * 6144;
    float zv[16];
    load16c(p.z + (size_t)tok * 1024, lane, zv);
    float s = 0.f;
#pragma unroll
    for (int j = 0; j < 16; ++j) { zv[j] = DN_ALPHA * zv[j] + m[5 * 1024 + lane * 16 + j] * o[j]; s += zv[j]; }
    const float mu = wave_sum(s) * (1.f / 1024.f);
    float q = 0.f;
#pragma unroll
    for (int j = 0; j < 16; ++j) { float dd = zv[j] - mu; q += dd * dd; }
    const float rs = rsqrtf(wave_sum(q) * (1.f / 1024.f) + LN_EPS);
    const float* lw = p.ln_w + (size_t)(l * 2 + 1) * 1024 + lane * 16;
    const float* lb = p.ln_b + (size_t)(l * 2 + 1) * 1024 + lane * 16;
#pragma unroll
    for (int j = 0; j < 16; ++j) zv[j] = (zv[j] - mu) * rs * lw[j] + lb[j];
    if (l == DEPTH - 1) {
      if (tok < NTX) store16c(p.out + (size_t)tok * 1024, lane, zv);
    } else {
      store16c(p.z + (size_t)tok * 1024, lane, zv);
      const float* m2 = p.mod + ((size_t)(l + 1) * 3 + mod_index(tok)) * 6144 + lane * 16;
      float hh[16];
#pragma unroll
      for (int j = 0; j < 16; ++j) hh[j] = zv[j] * (1.f + m2[1024 + j]) + m2[j];
      uint4 o0, o1;
      o0.x = pack2(hh[0], hh[1]); o0.y = pack2(hh[2], hh[3]); o0.z = pack2(hh[4], hh[5]); o0.w = pack2(hh[6], hh[7]);
      o1.x = pack2(hh[8], hh[9]); o1.y = pack2(hh[10], hh[11]); o1.z = pack2(hh[12], hh[13]); o1.w = pack2(hh[14], hh[15]);
      bf16_t* hd = p.h + (size_t)tok * 1024 + lane * 16;
      *(uint4*)hd = o0; *(uint4*)(hd + 8) = o1;
    }
  }
}

DEVI void run_phase(const Params& p, int ph, int l, char* smem) {
  if (ph == PH_PREP || ph == PH_TOPK) {
    const bool do_topk = ph == PH_TOPK;
    const bool do_prep = ph == PH_PREP || l < DEPTH - 1;
    const int lp = ph == PH_PREP ? l : l + 1;
    const bool prep_first = !do_topk || !((BID() >> 8) & 1);
#pragma unroll 1
    for (int step = 0; step < 2; ++step) {
      const bool prep_now = (step == 0) == prep_first;
      if (prep_now) { if (do_prep) phase_prep(p, lp, smem); }
      else { if (do_topk) phase_topk(p, l, smem); }
    }
    return;
  }
  switch (ph) {
    case PH_MOD: phase_mod(p, smem); break;
    case PH_PREP: break;
    case PH_G1: phase_g1(p, l, smem); break;
    case PH_CONV: phase_conv(p, l, smem); break;
    case PH_MLOC: phase_mloc(p, l, smem); break;
    case PH_SCAN: phase_scan(p); break;
    case PH_MOUT: phase_mout(p, l, smem); break;
    case PH_G2A: phase_g2a(p, l, smem); break;
    case PH_G3: phase_g3(p, l, smem); break;
    case PH_LN1: phase_ln1(p, l); break;
    case PH_G4: phase_g4(p, l, smem); break;
    case PH_TOPK: break;
    case PH_GATHER: phase_gather(p, l); break;
    default: break;
  }
}

__global__ void __launch_bounds__(256, 2) k_phase(Params p, int ph, int l) {
  extern __shared__ __attribute__((aligned(16))) char smem[];
  run_phase(p, ph, l, smem);
}

__global__ void __launch_bounds__(256, 2) k_mega(Params p) {
  extern __shared__ __attribute__((aligned(16))) char smem[];
  __shared__ uint4 xb_words;
  cg::grid_group grid = cg::this_grid();
  if (__builtin_amdgcn_workitem_id_x() == 0) xb_words = make_uint4(0u, 0u, 0u, 0u);
  __syncthreads();
  XcdBarrier xb = xcd_barrier_post(p.bar, (volatile LAS unsigned*)&xb_words);
  run_phase(p, PH_MOD, 0, smem);
  grid.sync();
  for (int l = 0; l < DEPTH; ++l) {
    for (int ph = (l == 0 ? PH_PREP : PH_G1); ph < PH_COUNT; ++ph) {
      run_phase(p, ph, l, smem);
#ifdef PROBE_PH
      if ((PROBE_PH >> ph) & 1) { xcd_barrier(xb); run_phase(p, ph, l, smem); }
#endif
      if (!(l == DEPTH - 1 && ph == PH_COUNT - 1)) xcd_barrier(xb);
    }
  }
}

extern "C" void kernel_launch(void* const* d_in, const int* in_sizes, int n_in, void* d_out, int out_size, void* d_ws,
                              size_t ws_size, hipStream_t stream) {
  Params p{};
  const float** pin = (const float**)&p;
  for (int i = 0; i < 24; ++i) pin[i] = (const float*)d_in[i];
  p.out = (float*)d_out;
  char* w = (char*)d_ws;
  size_t off = 0;
  auto take = [&](size_t bytes) { char* r = w + off; off += (bytes + 255) & ~(size_t)255; return r; };
  p.mod = (float*)take((size_t)4 * 3 * 6144 * 4);
  p.wt_in = (bf16_t*)take((size_t)INWP * 1024 * 2);
  p.wt_pa = (bf16_t*)take((size_t)1024 * 1024 * 2);
  p.wt_pb = (bf16_t*)take((size_t)1024 * 1024 * 2);
  p.wt_out = (bf16_t*)take((size_t)1024 * 1024 * 2);
  p.wt_q = (bf16_t*)take((size_t)2048 * 1024 * 2);
  p.keys = (bf16_t*)take((size_t)2 * 262144 * 2);
  p.eu = (unsigned char*)take((size_t)2 * 16384 * 1024);
  p.ev = (unsigned char*)take((size_t)2 * 16384 * 1024);
  p.escale = (float*)take((size_t)2 * 2 * 16384 * 4);
  p.z = (float*)take((size_t)NT * 1024 * 4);
  p.r = (float*)take((size_t)NT * 1024 * 4);
  p.h = (bf16_t*)take((size_t)NT * 1024 * 2);
  p.proj = (bf16_t*)take((size_t)NT * 8192 * 2);
  p.gates = (float*)take((size_t)NT * 32 * 4);
  p.q = (bf16_t*)take((size_t)NT * 1024 * 2);
  p.k = (bf16_t*)take((size_t)NT * 1024 * 2);
  p.sgu_stats = (float*)take((size_t)NT * 2 * 4);
  p.hA = (bf16_t*)take((size_t)NT * 1024 * 2);
  p.hB = (bf16_t*)take((size_t)NT * 1024 * 2);
  p.merged = (bf16_t*)take((size_t)NT * 1024 * 2);
  p.qry = p.proj;
  p.dC = (bf16_t*)take((size_t)2 * NITEM * 16384 * 2);
  p.Cin = (bf16_t*)take((size_t)2 * NITEM * 16384 * 2);
  p.dn = (float*)take((size_t)2 * NITEM * 128 * 4);
  p.nin = (float*)take((size_t)2 * NITEM * 128 * 4);
  p.cscal = (float*)take((size_t)2 * NITEM * 2 * 4);
  p.min_ = (float*)take((size_t)2 * NITEM * 4);
  p.eidx = (int*)take((size_t)NT * 128 * 4);
  p.egate = (float*)take((size_t)NT * 128 * 4);
  p.bar = (unsigned*)take((size_t)XCD_BAR_WORDS * 4);
  if (off > ws_size) { fprintf(stderr, "workspace too small: need %zu have %zu\n", off, ws_size); return; }

#if MEGA
  static int grid_blocks = 0;
  if (!grid_blocks) {
    (void)hipFuncSetAttribute((const void*)k_mega, hipFuncAttributeMaxDynamicSharedMemorySize, LDS_BYTES);
    int dev = 0, cus = 0, per_cu = 0;
    hipGetDevice(&dev);
    hipDeviceGetAttribute(&cus, hipDeviceAttributeMultiprocessorCount, dev);
    hipOccupancyMaxActiveBlocksPerMultiprocessor(&per_cu, k_mega, 256, LDS_BYTES);
    if (per_cu > 2) per_cu = 2;
    grid_blocks = cus * per_cu;
  }
  (void)hipMemsetAsync(p.bar, 0, (size_t)XCD_BAR_WORDS * 4, stream);
  void* args[] = {&p};
  hipError_t e = hipLaunchCooperativeKernel((void*)k_mega, dim3(grid_blocks), dim3(256), args, LDS_BYTES, stream);
  if (e != hipSuccess) fprintf(stderr, "cooperative launch failed: %s (grid %d)\n", hipGetErrorString(e), grid_blocks);
#else
  static bool attr = false;
  if (!attr) { (void)hipFuncSetAttribute((const void*)k_phase, hipFuncAttributeMaxDynamicSharedMemorySize, LDS_BYTES); attr = true; }
  const int grid = 512;
  k_phase<<<grid, 256, LDS_BYTES, stream>>>(p, PH_MOD, 0);
  for (int l = 0; l < DEPTH; ++l)
    for (int ph = PH_PREP; ph < PH_COUNT; ++ph) k_phase<<<grid, 256, LDS_BYTES, stream>>>(p, ph, l);
#endif
}
```
